# Optimizing an MI355X kernel written in HIP

```python
import math
import jax
import jax.numpy as jnp
from jax import lax
import numpy as np


D_MODEL = 2048
BATCH = 4
SEQ = 2048
DEPTH = 4

N_MIXERS = 3
N_META = 16
GRID_W = 64
NA_WIN_ROWS = 8
NA_WIN_COLS = 16
Q_BLOCK = 128

A_HEADS = 16
A_HEAD_DIM = D_MODEL // A_HEADS
A_WIDTH = A_HEADS * A_HEAD_DIM
B_HEADS = 8
B_HEAD_DIM = D_MODEL // (2 * B_HEADS)
B_WIDTH = 2 * B_HEADS * B_HEAD_DIM
C_HEADS = 16
C_KV_HEADS = 4
C_HEAD_DIM = D_MODEL // C_HEADS
C_WIDTH = C_HEADS * C_HEAD_DIM
C_WINDOW = 128

N_A = (DEPTH + 2) // 3
N_B = (DEPTH + 1) // 3
N_C = DEPTH // 3

DEEPNORM_ALPHA = (2 * DEPTH) ** 0.25
DEEPNORM_BETA = (8 * DEPTH) ** -0.25
LN_EPS = 1e-5
RMS_EPS = 1e-5
NEG_INF = -1e30

kernel_name = 'hybrid_na_diff_swa_deepnorm_encoder'

F32 = jnp.float32


def _layer_norm(x, g, b):
    xf = x.astype(F32)
    mu = jnp.mean(xf, -1, keepdims=True)
    var = jnp.mean(jnp.square(xf - mu), -1, keepdims=True)
    y = (xf - mu) * lax.rsqrt(var + LN_EPS) * g.astype(F32) + b.astype(F32)
    return y.astype(x.dtype)


def _alibi_slopes(n_heads):
    return jnp.exp2(-8.0 * jnp.arange(1, n_heads + 1, dtype=F32) / n_heads)


def _na_branch(h, w_in, rpb):
    Bn, L, _ = h.shape
    S = L - N_META
    rows = S // GRID_W
    wr = min(NA_WIN_ROWS, rows)
    H, dh = A_HEADS, A_HEAD_DIM
    proj = jnp.einsum('bld,de->ble', h, w_in)
    q, k, v, z = jnp.split(proj, 4, axis=-1)
    q = q.reshape(Bn, L, H, dh) * (dh ** -0.5)
    k = k.reshape(Bn, L, H, dh)
    v = v.reshape(Bn, L, H, dh)
    qm, km, vm = q[:, :N_META], k[:, :N_META], v[:, :N_META]
    s_mm = jnp.einsum('bqhd,bkhd->bhqk', qm, km).astype(F32)
    p_mm = jax.nn.softmax(s_mm, -1).astype(v.dtype)
    o_meta = jnp.einsum('bhqk,bkhd->bqhd', p_mm, vm)
    qg = q[:, N_META:].reshape(Bn, rows, GRID_W, H, dh)
    kg = k[:, N_META:].reshape(Bn, rows, GRID_W, H, dh)
    vg = v[:, N_META:].reshape(Bn, rows, GRID_W, H, dh)
    row_start = jnp.clip(jnp.arange(rows) - wr // 2, 0, rows - wr)
    col_pos = jnp.arange(GRID_W)
    col_start = jnp.clip(col_pos - NA_WIN_COLS // 2, 0, GRID_W - NA_WIN_COLS)
    col_idx = col_start[:, None] + jnp.arange(NA_WIN_COLS)[None]
    rpb_c = rpb[:, :, col_idx - col_pos[:, None] + NA_WIN_COLS - 1]

    def row_block(r):
        r0 = row_start[r]
        k_rows = lax.dynamic_slice_in_dim(kg, r0, wr, axis=1)
        v_rows = lax.dynamic_slice_in_dim(vg, r0, wr, axis=1)
        k_win = k_rows[:, :, col_idx]
        v_win = v_rows[:, :, col_idx]
        q_row = lax.dynamic_index_in_dim(qg, r, axis=1, keepdims=False)
        dr = r0 + jnp.arange(wr) - r
        bias = jnp.transpose(rpb_c[:, dr + NA_WIN_ROWS - 1], (0, 2, 1, 3))
        s_win = jnp.einsum('bqhd,biqjhd->bhqij', q_row, k_win).astype(F32) + bias[None].astype(F32)
        s_meta = jnp.einsum('bqhd,bkhd->bhqk', q_row, km).astype(F32)
        logits = jnp.concatenate([s_meta, s_win.reshape(Bn, H, GRID_W, wr * NA_WIN_COLS)], -1)
        p = jax.nn.softmax(logits, -1).astype(v.dtype)
        p_meta = p[..., :N_META]
        p_win = p[..., N_META:].reshape(Bn, H, GRID_W, wr, NA_WIN_COLS)
        return (jnp.einsum('bhqk,bkhd->bqhd', p_meta, vm)
                + jnp.einsum('bhqij,biqjhd->bqhd', p_win, v_win))

    o_grid = lax.map(row_block, jnp.arange(rows))
    o_grid = jnp.moveaxis(o_grid, 0, 1).reshape(Bn, S, H, dh)
    o = jnp.concatenate([o_meta, o_grid], 1).reshape(Bn, L, A_WIDTH)
    return o * jax.nn.silu(z)


def _diff_branch(h, w_in, lq1, lk1, lq2, lk2, subln_g, layer_idx):
    Bn, L, _ = h.shape
    S = L - N_META
    H, dh = B_HEADS, B_HEAD_DIM
    lambda_init = 0.8 - 0.6 * math.exp(-0.3 * layer_idx)
    proj = jnp.einsum('bld,de->ble', h, w_in)
    q, k, v, z = jnp.split(proj, 4, axis=-1)
    q = q.reshape(Bn, L, H, 2, dh) * (dh ** -0.5)
    k = k.reshape(Bn, L, H, 2, dh)
    v = v.reshape(Bn, L, H, 2 * dh)
    lam = (jnp.exp(jnp.sum(lq1.astype(F32) * lk1.astype(F32)))
           - jnp.exp(jnp.sum(lq2.astype(F32) * lk2.astype(F32))) + lambda_init)
    slopes = _alibi_slopes(H)
    key_pos = jnp.arange(S)

    def attend(q_blk, bias):
        s = jnp.einsum('bqhjd,bkhjd->bhjqk', q_blk, k).astype(F32) + bias[None, :, None]
        p = jax.nn.softmax(s, -1)
        a = p[:, :, 0] - lam * p[:, :, 1]
        return jnp.einsum('bhqk,bkhe->bqhe', a.astype(v.dtype), v)

    o_meta = attend(q[:, :N_META], jnp.zeros((H, N_META, L), F32))
    n_blk = S // Q_BLOCK
    q_real = q[:, N_META:].reshape(Bn, n_blk, Q_BLOCK, H, 2, dh)

    def block(n):
        q_blk = lax.dynamic_index_in_dim(q_real, n, axis=1, keepdims=False)
        q_pos = n * Q_BLOCK + jnp.arange(Q_BLOCK)
        dist = jnp.abs(q_pos[:, None] - key_pos[None]).astype(F32)
        bias = jnp.concatenate([jnp.zeros((H, Q_BLOCK, N_META), F32),
                                -slopes[:, None, None] * dist[None]], -1)
        return attend(q_blk, bias)

    o_real = lax.map(block, jnp.arange(n_blk))
    o_real = jnp.moveaxis(o_real, 0, 1).reshape(Bn, S, H, 2 * dh)
    o = jnp.concatenate([o_meta, o_real], 1).astype(F32)
    o = o * lax.rsqrt(jnp.mean(jnp.square(o), -1, keepdims=True) + RMS_EPS) * subln_g.astype(F32) * (1.0 - lambda_init)
    o = o.astype(h.dtype).reshape(Bn, L, B_WIDTH)
    return o * jax.nn.silu(z)


def _swa_branch(h, w_in, sink):
    Bn, L, _ = h.shape
    S = L - N_META
    Hk, dh = C_KV_HEADS, C_HEAD_DIM
    G = C_HEADS // C_KV_HEADS
    proj = jnp.einsum('bld,de->ble', h, w_in)
    q, k, v, z = jnp.split(proj, [C_WIDTH, C_WIDTH + Hk * dh, C_WIDTH + 2 * Hk * dh], axis=-1)
    q = q.reshape(Bn, L, Hk, G, dh) * (dh ** -0.5)
    k = k.reshape(Bn, L, Hk, dh)
    v = v.reshape(Bn, L, Hk, dh)
    km, vm = k[:, :N_META], v[:, :N_META]
    sink_l = sink.astype(F32).reshape(Hk, G)
    slopes = _alibi_slopes(C_HEADS).reshape(Hk, G)

    def attend(q_blk, k_blk, v_blk, bias):
        s = jnp.einsum('bqkgd,bskd->bkgqs', q_blk, k_blk).astype(F32) + bias[None]
        sk = jnp.broadcast_to(sink_l[None, :, :, None, None], s.shape[:-1] + (1,))
        p = jax.nn.softmax(jnp.concatenate([s, sk], -1), -1)[..., :-1]
        return jnp.einsum('bkgqs,bskd->bqkgd', p.astype(v_blk.dtype), v_blk)

    o_meta = attend(q[:, :N_META], km, vm, jnp.zeros((Hk, G, N_META, N_META), F32))
    n_blk = S // Q_BLOCK
    span = Q_BLOCK + 2 * C_WINDOW
    pad = ((0, 0), (C_WINDOW, C_WINDOW), (0, 0), (0, 0))
    k_pad = jnp.pad(k[:, N_META:], pad)
    v_pad = jnp.pad(v[:, N_META:], pad)
    q_real = q[:, N_META:].reshape(Bn, n_blk, Q_BLOCK, Hk, G, dh)

    def block(n):
        q0 = n * Q_BLOCK
        q_blk = lax.dynamic_index_in_dim(q_real, n, axis=1, keepdims=False)
        k_win = lax.dynamic_slice_in_dim(k_pad, q0, span, axis=1)
        v_win = lax.dynamic_slice_in_dim(v_pad, q0, span, axis=1)
        q_pos = q0 + jnp.arange(Q_BLOCK)
        k_pos = q0 - C_WINDOW + jnp.arange(span)
        dist = jnp.abs(q_pos[:, None] - k_pos[None])
        valid = (dist <= C_WINDOW) & (k_pos[None] >= 0) & (k_pos[None] < S)
        win_bias = jnp.where(valid[None, None],
                             -slopes[:, :, None, None] * dist.astype(F32)[None, None], NEG_INF)
        bias = jnp.concatenate([jnp.zeros((Hk, G, Q_BLOCK, N_META), F32), win_bias], -1)
        k_blk = jnp.concatenate([km, k_win], 1)
        v_blk = jnp.concatenate([vm, v_win], 1)
        return attend(q_blk, k_blk, v_blk, bias)

    o_real = lax.map(block, jnp.arange(n_blk))
    o_real = jnp.moveaxis(o_real, 0, 1).reshape(Bn, S, Hk, G, dh)
    o = jnp.concatenate([o_meta, o_real], 1).reshape(Bn, L, C_WIDTH)
    return o * jax.nn.silu(z)


def setup_inputs(seed: int = 0) -> dict:
    key = jax.random.key(seed)
    ks = jax.random.split(key, 16)
    nrm = jax.random.normal
    d_in = D_MODEL ** -0.5
    x = nrm(ks[0], (BATCH, SEQ, D_MODEL), F32)
    meta_tokens = nrm(ks[1], (N_META, D_MODEL), F32)
    w_in_a = nrm(ks[2], (N_A, D_MODEL, 4 * A_WIDTH), F32) * d_in
    rpb_a = nrm(ks[3], (N_A, A_HEADS, 2 * NA_WIN_ROWS - 1, 2 * NA_WIN_COLS - 1), F32) * 0.1
    w_in_b = nrm(ks[4], (N_B, D_MODEL, 4 * B_WIDTH), F32) * d_in
    lam_q1_b = nrm(ks[5], (N_B, B_HEAD_DIM), F32) * 0.1
    lam_k1_b = nrm(ks[6], (N_B, B_HEAD_DIM), F32) * 0.1
    lam_q2_b = nrm(ks[7], (N_B, B_HEAD_DIM), F32) * 0.1
    lam_k2_b = nrm(ks[8], (N_B, B_HEAD_DIM), F32) * 0.1
    subln_g_b = 1.0 + 0.02 * nrm(ks[9], (N_B, 2 * B_HEAD_DIM), F32)
    w_in_c = nrm(ks[10], (N_C, D_MODEL, 2 * C_WIDTH + 2 * C_KV_HEADS * C_HEAD_DIM), F32) * d_in
    sink_c = nrm(ks[11], (N_C, C_HEADS), F32)
    w_out = nrm(ks[12], (DEPTH, D_MODEL, D_MODEL), F32) * (D_MODEL ** -0.5) * DEEPNORM_BETA
    ln_g = 1.0 + 0.02 * nrm(ks[13], (DEPTH, D_MODEL), F32)
    ln_b = 0.02 * nrm(ks[14], (DEPTH, D_MODEL), F32)
    return {'x': x, 'meta_tokens': meta_tokens, 'w_in_a': w_in_a, 'rpb_a': rpb_a,
            'w_in_b': w_in_b, 'lam_q1_b': lam_q1_b, 'lam_k1_b': lam_k1_b,
            'lam_q2_b': lam_q2_b, 'lam_k2_b': lam_k2_b, 'subln_g_b': subln_g_b,
            'w_in_c': w_in_c, 'sink_c': sink_c, 'w_out': w_out, 'ln_g': ln_g, 'ln_b': ln_b}


def reference(x, meta_tokens, w_in_a, rpb_a, w_in_b, lam_q1_b, lam_k1_b, lam_q2_b,
              lam_k2_b, subln_g_b, w_in_c, sink_c, w_out, ln_g, ln_b):
    Bn = x.shape[0]
    meta = jnp.broadcast_to(meta_tokens.astype(x.dtype)[None], (Bn, N_META, D_MODEL))
    h = jnp.concatenate([meta, x], axis=1)
    for i in range(DEPTH):
        kind, j = i % N_MIXERS, i // N_MIXERS
        if kind == 0:
            y = _na_branch(h, w_in_a[j], rpb_a[j])
        elif kind == 1:
            y = _diff_branch(h, w_in_b[j], lam_q1_b[j], lam_k1_b[j], lam_q2_b[j],
                             lam_k2_b[j], subln_g_b[j], i)
        else:
            y = _swa_branch(h, w_in_c[j], sink_c[j])
        out = jnp.einsum('ble,ed->bld', y, w_out[i])
        h = _layer_norm(DEEPNORM_ALPHA * h + out, ln_g[i], ln_b[i])
    return h[:, N_META:]
```

```cpp
#include <hip/hip_runtime.h>
#include <cstdio>
#include <cstdint>

#define LAS __attribute__((address_space(3)))
typedef unsigned short bf16_t;
typedef unsigned v4u __attribute__((ext_vector_type(4)));
typedef float f32x4 __attribute__((ext_vector_type(4)));

constexpr int DM = 2048, NBATCH = 4, SEQ = 2048, NMETA = 16;
constexpr int MREAL = NBATCH * SEQ;
constexpr int MTOT = MREAL + NBATCH * NMETA;
constexpr int MPAD = 8448;
constexpr int NWAVES = 8, NTHREADS = 512;
constexpr float LN_EPS = 1e-5f, RMS_EPS = 1e-5f;
constexpr float ALPHA = 1.681792830507429f;
constexpr float QSCALE = 0.08838834764831845f;
constexpr float LAMBDA_INIT_L1 = 0.35550906759096f;

constexpr size_t MiB = 1u << 20;
constexpr size_t WS_WA0 = 0, WS_WA1 = 32 * MiB, WS_WB = 64 * MiB, WS_WC = 96 * MiB, WS_WO = 116 * MiB;
constexpr size_t WS_H32 = 148 * MiB;
constexpr size_t WS_HB = 214 * MiB;
constexpr size_t WS_Y = 247 * MiB;
constexpr size_t WS_P = 280 * MiB;
constexpr size_t WS_PRE = WS_P;
constexpr size_t WS_END = 412 * MiB;

struct Params {
    const float* x; const float* meta; const float* w_in_a; const float* rpb_a; const float* w_in_b;
    const float* lq1; const float* lk1; const float* lq2; const float* lk2; const float* subg;
    const float* w_in_c; const float* sink; const float* w_out; const float* ln_g; const float* ln_b;
    float* out; unsigned char* ws;
};

__device__ __forceinline__ float bf2f(bf16_t v) { return __uint_as_float(((unsigned)v) << 16); }
__device__ __forceinline__ unsigned f2bf(float f) { unsigned u = __float_as_uint(f); return (u + 0x7fffu + ((u >> 16) & 1u)) >> 16; }
__device__ __forceinline__ unsigned pk2(float lo, float hi) { return f2bf(lo) | (f2bf(hi) << 16); }
__device__ __forceinline__ float wave_sum(float v) {
#pragma unroll
    for (int o = 1; o < 64; o <<= 1) v += __shfl_xor(v, o);
    return v;
}
__device__ __forceinline__ float wave_max(float v) {
#pragma unroll
    for (int o = 1; o < 64; o <<= 1) v = fmaxf(v, __shfl_xor(v, o));
    return v;
}
__device__ __forceinline__ float silu(float z) { return z / (1.f + __expf(-z)); }

__device__ __forceinline__ void transpose_item(const float* W, int K, int N, bf16_t* WT, float* scr, int item, int lane) {
    const int nblk = N / 32, kb = item / nblk, nb = item % nblk, k0 = 64 * kb, n0 = 32 * nb;
#pragma unroll 8
    for (int i = 0; i < 32; ++i) { const int kk = 2 * i + (lane >> 5); scr[kk * 33 + (lane & 31)] = W[(size_t)(k0 + kk) * N + n0 + (lane & 31)]; }
    __builtin_amdgcn_s_waitcnt(0); asm volatile("" ::: "memory");
    const int c = lane & 7;
#pragma unroll
    for (int j = 0; j < 4; ++j) { const int n = (lane >> 3) + 8 * j; const float* s = scr + (8 * c) * 33 + n;
        v4u o; o.x = pk2(s[0 * 33], s[1 * 33]); o.y = pk2(s[2 * 33], s[3 * 33]); o.z = pk2(s[4 * 33], s[5 * 33]); o.w = pk2(s[6 * 33], s[7 * 33]);
        *(v4u*)(WT + (size_t)(n0 + n) * K + k0 + 8 * c) = o; }
    __builtin_amdgcn_s_waitcnt(0); asm volatile("" ::: "memory");
}
__device__ void phase_prep(const Params& p, float* lds) {
    const int tid = threadIdx.x, lane = tid & 63, wave = tid >> 6;
    float* scr = lds + wave * (64 * 33);
    const int gw = blockIdx.x * NWAVES + wave, NGW = gridDim.x * NWAVES;
    constexpr int I_A = 8192, I_C = 5120, I_O = 2048;
    constexpr int NITEMS = 3 * I_A + I_C + 4 * I_O;
    for (int it = gw; it < NITEMS; it += NGW) {
        int r = it;
        if (r < I_A) { transpose_item(p.w_in_a, DM, 8192, (bf16_t*)(p.ws + WS_WA0), scr, r, lane); continue; } r -= I_A;
        if (r < I_A) { transpose_item(p.w_in_a + (size_t)DM * 8192, DM, 8192, (bf16_t*)(p.ws + WS_WA1), scr, r, lane); continue; } r -= I_A;
        if (r < I_A) { transpose_item(p.w_in_b, DM, 8192, (bf16_t*)(p.ws + WS_WB), scr, r, lane); continue; } r -= I_A;
        if (r < I_C) { transpose_item(p.w_in_c, DM, 5120, (bf16_t*)(p.ws + WS_WC), scr, r, lane); continue; } r -= I_C;
        const int li = r / I_O; r -= li * I_O;
        transpose_item(p.w_out + (size_t)li * DM * DM, DM, DM, (bf16_t*)(p.ws + WS_WO) + (size_t)li * DM * DM, scr, r, lane);
    }
    float* H32 = (float*)(p.ws + WS_H32); bf16_t* HB = (bf16_t*)(p.ws + WS_HB);
    for (int R = gw; R < MPAD; R += NGW) {
        const float* src = nullptr;
        if (R < MREAL) src = p.x + (size_t)R * DM; else if (R < MTOT) src = p.meta + (size_t)((R - MREAL) & 15) * DM;
#pragma unroll
        for (int j = 0; j < 8; ++j) {
            const int c = j * 256 + lane * 4;
            f32x4 v = src ? *(const f32x4*)(src + c) : (f32x4){0.f, 0.f, 0.f, 0.f};
            *(f32x4*)(H32 + (size_t)R * DM + c) = v;
            uint2 o; o.x = pk2(v[0], v[1]); o.y = pk2(v[2], v[3]);
            *(uint2*)(HB + (size_t)R * DM + c) = o;
        }
    }
}

template <int MODE>
__device__ void phase_gemm_naive(const bf16_t* A, const bf16_t* Bt, int M, int N, int K, void* Cout, const float* H32, float* lds) {
    const int tid = threadIdx.x, ty = tid >> 4, tx = tid & 15;
    float* As = lds;
    float* Bs = lds + 32 * 132;
    const int ntm = M / 128, ntn = N / 64, ntiles = ntm * ntn;
    for (int t = blockIdx.x; t < ntiles; t += gridDim.x) {
        const int tm = t / ntn, tn = t % ntn, m0 = tm * 128, n0 = tn * 64;
        float acc[4][4];
#pragma unroll
        for (int i = 0; i < 4; ++i)
#pragma unroll
            for (int j = 0; j < 4; ++j) acc[i][j] = 0.f;
        for (int k0 = 0; k0 < K; k0 += 32) {
            __syncthreads();
            { const int r = tid >> 2, kc = (tid & 3) * 8; const v4u v = *(const v4u*)(A + (size_t)(m0 + r) * K + k0 + kc);
#pragma unroll
              for (int j = 0; j < 4; ++j) { As[(kc + 2 * j) * 132 + r] = __uint_as_float(v[j] << 16); As[(kc + 2 * j + 1) * 132 + r] = __uint_as_float(v[j] & 0xffff0000u); } }
            if (tid < 256) { const int r = tid >> 2, kc = (tid & 3) * 8; const v4u v = *(const v4u*)(Bt + (size_t)(n0 + r) * K + k0 + kc);
#pragma unroll
              for (int j = 0; j < 4; ++j) { Bs[(kc + 2 * j) * 68 + r] = __uint_as_float(v[j] << 16); Bs[(kc + 2 * j + 1) * 68 + r] = __uint_as_float(v[j] & 0xffff0000u); } }
            __syncthreads();
#pragma unroll 8
            for (int k = 0; k < 32; ++k) {
                const f32x4 a = *(const f32x4*)(As + k * 132 + ty * 4), b = *(const f32x4*)(Bs + k * 68 + tx * 4);
#pragma unroll
                for (int i = 0; i < 4; ++i)
#pragma unroll
                    for (int j = 0; j < 4; ++j) acc[i][j] += a[i] * b[j];
            }
        }
#pragma unroll
        for (int i = 0; i < 4; ++i) {
            const int row = m0 + ty * 4 + i, col = n0 + tx * 4;
            if (MODE == 0) { uint2 o; o.x = pk2(acc[i][0], acc[i][1]); o.y = pk2(acc[i][2], acc[i][3]); *(uint2*)((bf16_t*)Cout + (size_t)row * N + col) = o; }
            else { const f32x4 h = *(const f32x4*)(H32 + (size_t)row * DM + col); f32x4 o;
#pragma unroll
                for (int j = 0; j < 4; ++j) o[j] = ALPHA * h[j] + acc[i][j];
                *(f32x4*)((float*)Cout + (size_t)row * DM + col) = o; }
        }
    }
}

__device__ __forceinline__ float dot128(const float* q, const bf16_t* k) {
    float s = 0.f;
#pragma unroll 4
    for (int c = 0; c < 16; ++c) { const v4u v = *(const v4u*)(k + c * 8);
#pragma unroll
        for (int j = 0; j < 4; ++j) { s += q[c * 8 + 2 * j] * __uint_as_float(v[j] << 16); s += q[c * 8 + 2 * j + 1] * __uint_as_float(v[j] & 0xffff0000u); } }
    return s;
}

__device__ void phase_attn_na(const Params& p, const float* rpb, float* lds) {
    const int tid = threadIdx.x, lane = tid & 63, wave = tid >> 6;
    float* qs = lds + wave * 512; float* ps = qs + 128;
    const bf16_t* P = (const bf16_t*)(p.ws + WS_P); bf16_t* Y = (bf16_t*)(p.ws + WS_Y);
    const int gw = blockIdx.x * NWAVES + wave, NGW = gridDim.x * NWAVES;
    for (int task = gw; task < MTOT * 16; task += NGW) {
        const int R = task >> 4, h = task & 15;
        const bf16_t* qrow = P + (size_t)R * 8192 + h * 128;
        qs[lane] = bf2f(qrow[lane]); qs[lane + 64] = bf2f(qrow[lane + 64]);
        __builtin_amdgcn_s_waitcnt(0); asm volatile("" ::: "memory");
        int nkeys, b, r = 0, c = 0, r0 = 0, c0 = 0; const bool meta = R >= MREAL;
        if (meta) { b = (R - MREAL) >> 4; nkeys = 16; }
        else { b = R >> 11; const int s = R & 2047; r = s >> 6; c = s & 63; r0 = min(max(r - 4, 0), 24); c0 = min(max(c - 8, 0), 48); nkeys = 144; }
        float sc[3]; float mx = -3.0e38f;
#pragma unroll
        for (int it = 0; it < 3; ++it) {
            const int idx = it * 64 + lane; sc[it] = -3.0e38f;
            if (idx < nkeys) {
                int krow; float bias = 0.f;
                if (idx < 16) krow = MREAL + b * 16 + idx;
                else { const int i = (idx - 16) >> 4, j = (idx - 16) & 15; krow = b * 2048 + (r0 + i) * 64 + (c0 + j);
                       bias = rpb[(h * 15 + (r0 + i - r + 7)) * 31 + (c0 + j - c + 15)]; }
                sc[it] = dot128(qs, P + (size_t)krow * 8192 + 2048 + h * 128) * QSCALE + bias;
            }
            mx = fmaxf(mx, sc[it]);
        }
        mx = wave_max(mx);
        float sum = 0.f;
#pragma unroll
        for (int it = 0; it < 3; ++it) { const int idx = it * 64 + lane; float e = 0.f; if (idx < nkeys) e = __expf(sc[it] - mx); sum += e; if (idx < 192) ps[idx] = e; }
        sum = wave_sum(sum);
        __builtin_amdgcn_s_waitcnt(0); asm volatile("" ::: "memory");
        const float inv = 1.f / sum;
        float o0 = 0.f, o1 = 0.f;
        for (int idx = 0; idx < nkeys; ++idx) {
            int krow;
            if (idx < 16) krow = MREAL + b * 16 + idx;
            else { const int i = (idx - 16) >> 4, j = (idx - 16) & 15; krow = b * 2048 + (r0 + i) * 64 + (c0 + j); }
            const unsigned v = *(const unsigned*)(P + (size_t)krow * 8192 + 4096 + h * 128 + 2 * lane);
            const float pw = ps[idx];
            o0 += pw * __uint_as_float(v << 16); o1 += pw * __uint_as_float(v & 0xffff0000u);
        }
        const unsigned zz = *(const unsigned*)(P + (size_t)R * 8192 + 6144 + h * 128 + 2 * lane);
        const float y0 = o0 * inv * silu(__uint_as_float(zz << 16)), y1 = o1 * inv * silu(__uint_as_float(zz & 0xffff0000u));
        *(unsigned*)(Y + (size_t)R * DM + h * 128 + 2 * lane) = pk2(y0, y1);
        __builtin_amdgcn_s_waitcnt(0); asm volatile("" ::: "memory");
    }
}

__device__ void phase_attn_diff(const Params& p, float* lds) {
    const int tid = threadIdx.x, lane = tid & 63, wave = tid >> 6;
    float* qs = lds + wave * 2304; float* as = qs + 128;
    const bf16_t* P = (const bf16_t*)(p.ws + WS_P); bf16_t* Y = (bf16_t*)(p.ws + WS_Y);
    const int gw = blockIdx.x * NWAVES + wave, NGW = gridDim.x * NWAVES;
    float l1 = 0.f, l2 = 0.f;
    { l1 = p.lq1[lane] * p.lk1[lane] + p.lq1[lane + 64] * p.lk1[lane + 64]; l2 = p.lq2[lane] * p.lk2[lane] + p.lq2[lane + 64] * p.lk2[lane + 64]; }
    const float lam = __expf(wave_sum(l1)) - __expf(wave_sum(l2)) + LAMBDA_INIT_L1;
    constexpr int LK = 2064, NIT = (LK + 63) / 64;
    for (int task = gw; task < MTOT * 8; task += NGW) {
        const int R = task >> 3, h = task & 7;
        const bool meta = R >= MREAL; const int b = meta ? (R - MREAL) >> 4 : R >> 11; const int s = R & 2047;
        const float slope = exp2f(-(float)(h + 1));
        for (int j = 0; j < 2; ++j) {
            const bf16_t* qrow = P + (size_t)R * 8192 + h * 256 + j * 128;
            __builtin_amdgcn_s_waitcnt(0); asm volatile("" ::: "memory");
            qs[lane] = bf2f(qrow[lane]); qs[lane + 64] = bf2f(qrow[lane + 64]);
            __builtin_amdgcn_s_waitcnt(0); asm volatile("" ::: "memory");
            float mx = -3.0e38f;
            float sc[NIT];
#pragma unroll
            for (int it = 0; it < NIT; ++it) {
                const int idx = it * 64 + lane; sc[it] = -3.0e38f;
                if (idx < LK) {
                    int krow; float bias = 0.f;
                    if (idx < 16) krow = MREAL + b * 16 + idx;
                    else { const int t = idx - 16; krow = b * 2048 + t; if (!meta) bias = -slope * fabsf((float)(s - t)); }
                    sc[it] = dot128(qs, P + (size_t)krow * 8192 + 2048 + h * 256 + j * 128) * QSCALE + bias;
                }
                mx = fmaxf(mx, sc[it]);
            }
            mx = wave_max(mx);
            float sum = 0.f;
#pragma unroll
            for (int it = 0; it < NIT; ++it) { const int idx = it * 64 + lane; if (idx < LK) { sc[it] = __expf(sc[it] - mx); sum += sc[it]; } else sc[it] = 0.f; }
            sum = wave_sum(sum);
            const float inv = 1.f / sum;
#pragma unroll
            for (int it = 0; it < NIT; ++it) { const int idx = it * 64 + lane; if (j == 0) as[idx] = sc[it] * inv; else as[idx] -= lam * sc[it] * inv; }
        }
        __builtin_amdgcn_s_waitcnt(0); asm volatile("" ::: "memory");
        float o[4] = {0.f, 0.f, 0.f, 0.f};
        for (int idx = 0; idx < LK; ++idx) {
            const int krow = idx < 16 ? MREAL + b * 16 + idx : b * 2048 + idx - 16;
            const uint2 v = *(const uint2*)(P + (size_t)krow * 8192 + 4096 + h * 256 + 4 * lane);
            const float a = as[idx];
            o[0] += a * __uint_as_float(v.x << 16); o[1] += a * __uint_as_float(v.x & 0xffff0000u);
            o[2] += a * __uint_as_float(v.y << 16); o[3] += a * __uint_as_float(v.y & 0xffff0000u);
        }
        const float ss = wave_sum(o[0] * o[0] + o[1] * o[1] + o[2] * o[2] + o[3] * o[3]);
        const float rinv = 1.f / sqrtf(ss * (1.f / 256.f) + RMS_EPS) * (1.f - LAMBDA_INIT_L1);
        const f32x4 g = *(const f32x4*)(p.subg + 4 * lane);
        const uint2 zz = *(const uint2*)(P + (size_t)R * 8192 + 6144 + h * 256 + 4 * lane);
        const float y0 = o[0] * rinv * g[0] * silu(__uint_as_float(zz.x << 16)), y1 = o[1] * rinv * g[1] * silu(__uint_as_float(zz.x & 0xffff0000u));
        const float y2 = o[2] * rinv * g[2] * silu(__uint_as_float(zz.y << 16)), y3 = o[3] * rinv * g[3] * silu(__uint_as_float(zz.y & 0xffff0000u));
        uint2 ov; ov.x = pk2(y0, y1); ov.y = pk2(y2, y3);
        *(uint2*)(Y + (size_t)R * DM + h * 256 + 4 * lane) = ov;
    }
}

__device__ void phase_attn_swa(const Params& p, float* lds) {
    const int tid = threadIdx.x, lane = tid & 63, wave = tid >> 6;
    float* qs = lds + wave * 512; float* ps = qs + 128;
    const bf16_t* P = (const bf16_t*)(p.ws + WS_P); bf16_t* Y = (bf16_t*)(p.ws + WS_Y);
    const int gw = blockIdx.x * NWAVES + wave, NGW = gridDim.x * NWAVES;
    constexpr int LDP = 5120;
    for (int task = gw; task < MTOT * 16; task += NGW) {
        const int R = task >> 4, hd = task & 15, kh = hd >> 2;
        const bf16_t* qrow = P + (size_t)R * LDP + hd * 128;
        qs[lane] = bf2f(qrow[lane]); qs[lane + 64] = bf2f(qrow[lane + 64]);
        __builtin_amdgcn_s_waitcnt(0); asm volatile("" ::: "memory");
        const bool meta = R >= MREAL; const int b = meta ? (R - MREAL) >> 4 : R >> 11; const int s = R & 2047;
        const int tlo = meta ? 0 : max(s - 128, 0), thi = meta ? -1 : min(s + 128, 2047);
        const int nkeys = 16 + (thi - tlo + 1);
        const float slope = exp2f(-0.5f * (float)(hd + 1)), sinkv = p.sink[hd];
        float sc[5]; float mx = sinkv;
#pragma unroll
        for (int it = 0; it < 5; ++it) {
            const int idx = it * 64 + lane; sc[it] = -3.0e38f;
            if (idx < nkeys) {
                int krow; float bias = 0.f;
                if (idx < 16) krow = MREAL + b * 16 + idx;
                else { const int t = tlo + idx - 16; krow = b * 2048 + t; bias = -slope * fabsf((float)(s - t)); }
                sc[it] = dot128(qs, P + (size_t)krow * LDP + 2048 + kh * 128) * QSCALE + bias;
            }
            mx = fmaxf(mx, sc[it]);
        }
        mx = wave_max(mx);
        float sum = 0.f;
#pragma unroll
        for (int it = 0; it < 5; ++it) { const int idx = it * 64 + lane; float e = 0.f; if (idx < nkeys) e = __expf(sc[it] - mx); sum += e; ps[idx] = e; }
        sum = wave_sum(sum) + __expf(sinkv - mx);
        __builtin_amdgcn_s_waitcnt(0); asm volatile("" ::: "memory");
        const float inv = 1.f / sum;
        float o0 = 0.f, o1 = 0.f;
        for (int idx = 0; idx < nkeys; ++idx) {
            const int krow = idx < 16 ? MREAL + b * 16 + idx : b * 2048 + tlo + idx - 16;
            const unsigned v = *(const unsigned*)(P + (size_t)krow * LDP + 2560 + kh * 128 + 2 * lane);
            const float pw = ps[idx];
            o0 += pw * __uint_as_float(v << 16); o1 += pw * __uint_as_float(v & 0xffff0000u);
        }
        const unsigned zz = *(const unsigned*)(P + (size_t)R * LDP + 3072 + hd * 128 + 2 * lane);
        const float y0 = o0 * inv * silu(__uint_as_float(zz << 16)), y1 = o1 * inv * silu(__uint_as_float(zz & 0xffff0000u));
        *(unsigned*)(Y + (size_t)R * DM + hd * 128 + 2 * lane) = pk2(y0, y1);
        __builtin_amdgcn_s_waitcnt(0); asm volatile("" ::: "memory");
    }
}

__device__ void phase_ln(const Params& p, int layer, bool last) {
    const int tid = threadIdx.x, lane = tid & 63, wave = tid >> 6;
    const int gw = blockIdx.x * NWAVES + wave, NGW = gridDim.x * NWAVES;
    const float* PRE = (const float*)(p.ws + WS_PRE); float* H32 = (float*)(p.ws + WS_H32); bf16_t* HB = (bf16_t*)(p.ws + WS_HB);
    const float* g = p.ln_g + layer * DM; const float* bb = p.ln_b + layer * DM;
    for (int R = gw; R < MTOT; R += NGW) {
        f32x4 v[8]; float s = 0.f;
#pragma unroll
        for (int j = 0; j < 8; ++j) { v[j] = *(const f32x4*)(PRE + (size_t)R * DM + j * 256 + lane * 4); s += (v[j][0] + v[j][1]) + (v[j][2] + v[j][3]); }
        const float mean = wave_sum(s) * (1.f / DM); float s2 = 0.f;
#pragma unroll
        for (int j = 0; j < 8; ++j) { v[j] = v[j] - mean; s2 += (v[j][0] * v[j][0] + v[j][1] * v[j][1]) + (v[j][2] * v[j][2] + v[j][3] * v[j][3]); }
        const float rstd = 1.f / sqrtf(wave_sum(s2) * (1.f / DM) + LN_EPS);
#pragma unroll
        for (int j = 0; j < 8; ++j) {
            const int c = j * 256 + lane * 4;
            const f32x4 gg = *(const f32x4*)(g + c), bv = *(const f32x4*)(bb + c);
            f32x4 o = v[j] * rstd * gg + bv;
            if (last) { if (R < MREAL) *(f32x4*)(p.out + (size_t)R * DM + c) = o; }
            else { *(f32x4*)(H32 + (size_t)R * DM + c) = o; uint2 w; w.x = pk2(o[0], o[1]); w.y = pk2(o[2], o[3]); *(uint2*)(HB + (size_t)R * DM + c) = w; }
        }
    }
}

__global__ void __launch_bounds__(NTHREADS) k_phase(Params p, int phase, int layer) {
    extern __shared__ __attribute__((aligned(16))) float lds[];
    const bf16_t* HB = (const bf16_t*)(p.ws + WS_HB);
    if (phase == 0) { phase_prep(p, lds); return; }
    const int kind = layer % 3;
    if (phase == 1) {
        const bf16_t* Wt = (const bf16_t*)(p.ws + (layer == 0 ? WS_WA0 : layer == 1 ? WS_WB : layer == 2 ? WS_WC : WS_WA1));
        phase_gemm_naive<0>(HB, Wt, MPAD, kind == 2 ? 5120 : 8192, DM, p.ws + WS_P, nullptr, lds);
    } else if (phase == 2) {
        if (kind == 0) phase_attn_na(p, p.rpb_a + (size_t)(layer / 3) * 16 * 15 * 31, lds);
        else if (kind == 1) phase_attn_diff(p, lds);
        else phase_attn_swa(p, lds);
    } else if (phase == 3) {
        phase_gemm_naive<1>((const bf16_t*)(p.ws + WS_Y), (const bf16_t*)(p.ws + WS_WO) + (size_t)layer * DM * DM, MPAD, DM, DM, p.ws + WS_PRE, (const float*)(p.ws + WS_H32), lds);
    } else if (phase == 4) {
        phase_ln(p, layer, layer == 3);
    }
}

extern "C" void kernel_launch(void* const* d_in, const int* in_sizes, int n_in, void* d_out, int out_size, void* d_ws, size_t ws_size, hipStream_t stream) {
    if (n_in != 15 || ws_size < WS_END) { fprintf(stderr, "kernel_launch: unexpected n_in %d or ws_size %zu (< %zu)\n", n_in, ws_size, (size_t)WS_END); return; }
    Params p{};
    p.x = (const float*)d_in[0]; p.meta = (const float*)d_in[1]; p.w_in_a = (const float*)d_in[2]; p.rpb_a = (const float*)d_in[3]; p.w_in_b = (const float*)d_in[4];
    p.lq1 = (const float*)d_in[5]; p.lk1 = (const float*)d_in[6]; p.lq2 = (const float*)d_in[7]; p.lk2 = (const float*)d_in[8]; p.subg = (const float*)d_in[9];
    p.w_in_c = (const float*)d_in[10]; p.sink = (const float*)d_in[11]; p.w_out = (const float*)d_in[12]; p.ln_g = (const float*)d_in[13]; p.ln_b = (const float*)d_in[14];
    p.out = (float*)d_out; p.ws = (unsigned char*)d_ws;
    const int LDSB = 80 * 1024;
    static bool attr_set = false;
    if (!attr_set) { (void)hipFuncSetAttribute((const void*)k_phase, hipFuncAttributeMaxDynamicSharedMemorySize, LDSB); attr_set = true; }
    const int grid = 1024;
    hipLaunchKernelGGL(k_phase, dim3(grid), dim3(NTHREADS), LDSB, stream, p, 0, 0);
    for (int layer = 0; layer < 4; ++layer)
        for (int ph = 1; ph <= 4; ++ph) hipLaunchKernelGGL(k_phase, dim3(grid), dim3(NTHREADS), LDSB, stream, p, ph, layer);
}
```

```cpp
#include <hip/hip_runtime.h>
#include <cstdio>
#include <cstdint>

#define LAS __attribute__((address_space(3)))
typedef unsigned short bf16_t;
typedef unsigned v4u __attribute__((ext_vector_type(4)));
typedef float f32x4 __attribute__((ext_vector_type(4)));

constexpr int DM = 2048, NBATCH = 4, SEQ = 2048, NMETA = 16;
constexpr int MREAL = NBATCH * SEQ;
constexpr int MTOT = MREAL + NBATCH * NMETA;
constexpr int MPAD = 8448;
constexpr int NWAVES = 8, NTHREADS = 512;
constexpr int LDS_TOTAL = 144 * 1024, LDS_MISC = LDS_TOTAL - 256;
constexpr float LN_EPS = 1e-5f, RMS_EPS = 1e-5f;
constexpr float ALPHA = 1.681792830507429f;
constexpr float QSCALE = 0.6931471805599453f;
constexpr float QPRE = 0.08838834764831845f * 1.4426950408889634f;
constexpr float LAMBDA_INIT_L1 = 0.35550906759096f;

constexpr size_t MiB = 1u << 20;
constexpr size_t WS_WA0 = 0, WS_WA1 = 32 * MiB, WS_WB = 64 * MiB, WS_WC = 96 * MiB, WS_WO = 116 * MiB;
constexpr size_t WS_H32 = 148 * MiB;
constexpr size_t WS_HB = 214 * MiB;
constexpr size_t WS_Y = 247 * MiB;
constexpr size_t WS_P = 280 * MiB;
constexpr size_t WS_PRE = WS_P;
constexpr size_t WS_OD = 412 * MiB;
constexpr size_t WS_CTL = 478 * MiB, CTL_BYTES = 64 * 1024;
constexpr size_t WS_ST = 479 * MiB;
constexpr size_t WS_END = 480 * MiB;

struct Params {
    const float* x; const float* meta; const float* w_in_a; const float* rpb_a; const float* w_in_b;
    const float* lq1; const float* lk1; const float* lq2; const float* lk2; const float* subg;
    const float* w_in_c; const float* sink; const float* w_out; const float* ln_g; const float* ln_b;
    float* out; unsigned char* ws;
};

__device__ __forceinline__ float bf2f(bf16_t v) { return __uint_as_float(((unsigned)v) << 16); }
__device__ __forceinline__ unsigned f2bf(float f) { unsigned u = __float_as_uint(f); return (u + 0x7fffu + ((u >> 16) & 1u)) >> 16; }
__device__ __forceinline__ unsigned pk2(float lo, float hi) { return f2bf(lo) | (f2bf(hi) << 16); }
__device__ __forceinline__ float wave_sum(float v) {
#pragma unroll
    for (int o = 1; o < 64; o <<= 1) v += __shfl_xor(v, o);
    return v;
}
__device__ __forceinline__ float wave_max(float v) {
#pragma unroll
    for (int o = 1; o < 64; o <<= 1) v = fmaxf(v, __shfl_xor(v, o));
    return v;
}
__device__ __forceinline__ float silu(float z) { return z / (1.f + __expf(-z)); }

__device__ __forceinline__ void transpose_item(const float* W, int K, int N, bf16_t* WT, float* scr, int item, int lane) {
    const int nblk = N / 32, kb = item / nblk, nb = item % nblk, k0 = 64 * kb, n0 = 32 * nb;
#pragma unroll 8
    for (int i = 0; i < 32; ++i) { const int kk = 2 * i + (lane >> 5); scr[kk * 33 + (lane & 31)] = W[(size_t)(k0 + kk) * N + n0 + (lane & 31)]; }
    __builtin_amdgcn_s_waitcnt(0); asm volatile("" ::: "memory");
    const int c = lane & 7;
#pragma unroll
    for (int j = 0; j < 4; ++j) { const int n = (lane >> 3) + 8 * j; const float* s = scr + (8 * c) * 33 + n;
        v4u o; o.x = pk2(s[0 * 33], s[1 * 33]); o.y = pk2(s[2 * 33], s[3 * 33]); o.z = pk2(s[4 * 33], s[5 * 33]); o.w = pk2(s[6 * 33], s[7 * 33]);
        *(v4u*)(WT + (size_t)(n0 + n) * K + k0 + 8 * c) = o; }
    __builtin_amdgcn_s_waitcnt(0); asm volatile("" ::: "memory");
}
__device__ __forceinline__ void phase_prep(const Params& p, float* lds) {
    int tid = threadIdx.x; asm volatile("" : "+v"(tid)); const int lane = tid & 63, wave = tid >> 6;
    float* scr = lds + wave * (64 * 33);
    const int gw = blockIdx.x * NWAVES + wave, NGW = gridDim.x * NWAVES;
    constexpr int I_A = 8192, I_C = 5120, I_O = 2048;
    constexpr int NITEMS = 3 * I_A + I_C + 4 * I_O;
    for (int it = gw; it < NITEMS; it += NGW) {
        int r = it;
        if (r < I_A) { transpose_item(p.w_in_a, DM, 8192, (bf16_t*)(p.ws + WS_WA0), scr, r, lane); continue; } r -= I_A;
        if (r < I_A) { transpose_item(p.w_in_a + (size_t)DM * 8192, DM, 8192, (bf16_t*)(p.ws + WS_WA1), scr, r, lane); continue; } r -= I_A;
        if (r < I_A) { transpose_item(p.w_in_b, DM, 8192, (bf16_t*)(p.ws + WS_WB), scr, r, lane); continue; } r -= I_A;
        if (r < I_C) { transpose_item(p.w_in_c, DM, 5120, (bf16_t*)(p.ws + WS_WC), scr, r, lane); continue; } r -= I_C;
        const int li = r / I_O; r -= li * I_O;
        transpose_item(p.w_out + (size_t)li * DM * DM, DM, DM, (bf16_t*)(p.ws + WS_WO) + (size_t)li * DM * DM, scr, r, lane);
    }
    float* H32 = (float*)(p.ws + WS_H32); bf16_t* HB = (bf16_t*)(p.ws + WS_HB);
    for (int R = gw; R < MTOT; R += NGW) {
        const float* src = nullptr;
        if (R < MREAL) src = p.x + (size_t)R * DM; else if (R < MTOT) src = p.meta + (size_t)((R - MREAL) & 15) * DM;
#pragma unroll
        for (int j = 0; j < 8; ++j) {
            const int c = j * 256 + lane * 4;
            f32x4 v = src ? *(const f32x4*)(src + c) : (f32x4){0.f, 0.f, 0.f, 0.f};
            if (R >= MREAL) *(f32x4*)(H32 + (size_t)R * DM + c) = v;
            uint2 o; o.x = pk2(v[0], v[1]); o.y = pk2(v[2], v[3]);
            *(uint2*)(HB + (size_t)R * DM + c) = o;
        }
    }
}

template <int MODE>
__device__ __forceinline__ void phase_gemm_naive(const bf16_t* A, const bf16_t* Bt, int M, int N, int K, void* Cout, const float* H32, float* lds) {
    const int tid = threadIdx.x, ty = tid >> 4, tx = tid & 15;
    float* As = lds;
    float* Bs = lds + 32 * 132;
    const int ntm = M / 128, ntn = N / 64, ntiles = ntm * ntn;
    for (int t = blockIdx.x; t < ntiles; t += gridDim.x) {
        const int tm = t / ntn, tn = t % ntn, m0 = tm * 128, n0 = tn * 64;
        float acc[4][4];
#pragma unroll
        for (int i = 0; i < 4; ++i)
#pragma unroll
            for (int j = 0; j < 4; ++j) acc[i][j] = 0.f;
        for (int k0 = 0; k0 < K; k0 += 32) {
            __syncthreads();
            { const int r = tid >> 2, kc = (tid & 3) * 8; const v4u v = *(const v4u*)(A + (size_t)(m0 + r) * K + k0 + kc);
#pragma unroll
              for (int j = 0; j < 4; ++j) { As[(kc + 2 * j) * 132 + r] = __uint_as_float(v[j] << 16); As[(kc + 2 * j + 1) * 132 + r] = __uint_as_float(v[j] & 0xffff0000u); } }
            if (tid < 256) { const int r = tid >> 2, kc = (tid & 3) * 8; const v4u v = *(const v4u*)(Bt + (size_t)(n0 + r) * K + k0 + kc);
#pragma unroll
              for (int j = 0; j < 4; ++j) { Bs[(kc + 2 * j) * 68 + r] = __uint_as_float(v[j] << 16); Bs[(kc + 2 * j + 1) * 68 + r] = __uint_as_float(v[j] & 0xffff0000u); } }
            __syncthreads();
#pragma unroll 8
            for (int k = 0; k < 32; ++k) {
                const f32x4 a = *(const f32x4*)(As + k * 132 + ty * 4), b = *(const f32x4*)(Bs + k * 68 + tx * 4);
#pragma unroll
                for (int i = 0; i < 4; ++i)
#pragma unroll
                    for (int j = 0; j < 4; ++j) acc[i][j] += a[i] * b[j];
            }
        }
#pragma unroll
        for (int i = 0; i < 4; ++i) {
            const int row = m0 + ty * 4 + i, col = n0 + tx * 4;
            if (MODE == 0) { uint2 o; o.x = pk2(acc[i][0], acc[i][1]); o.y = pk2(acc[i][2], acc[i][3]); *(uint2*)((bf16_t*)Cout + (size_t)row * N + col) = o; }
            else { const f32x4 h = *(const f32x4*)(H32 + (size_t)row * DM + col); f32x4 o;
#pragma unroll
                for (int j = 0; j < 4; ++j) o[j] = ALPHA * h[j] + acc[i][j];
                *(f32x4*)((float*)Cout + (size_t)row * DM + col) = o; }
        }
    }
}

__device__ __forceinline__ float dot128(const float* q, const bf16_t* k) {
    float s = 0.f;
#pragma unroll 4
    for (int c = 0; c < 16; ++c) { const v4u v = *(const v4u*)(k + c * 8);
#pragma unroll
        for (int j = 0; j < 4; ++j) { s += q[c * 8 + 2 * j] * __uint_as_float(v[j] << 16); s += q[c * 8 + 2 * j + 1] * __uint_as_float(v[j] & 0xffff0000u); } }
    return s;
}

__device__ __forceinline__ void phase_attn_na(const Params& p, const float* rpb, float* lds) {
    int tid = threadIdx.x; asm volatile("" : "+v"(tid)); const int lane = tid & 63, wave = tid >> 6;
    float* qs = lds + wave * 512; float* ps = qs + 128;
    const bf16_t* P = (const bf16_t*)(p.ws + WS_P); bf16_t* Y = (bf16_t*)(p.ws + WS_Y);
    const int gw = blockIdx.x * NWAVES + wave, NGW = gridDim.x * NWAVES;
    for (int task = gw; task < MTOT * 16; task += NGW) {
        const int R = task >> 4, h = task & 15;
        const bf16_t* qrow = P + (size_t)R * 8192 + h * 128;
        qs[lane] = bf2f(qrow[lane]); qs[lane + 64] = bf2f(qrow[lane + 64]);
        __builtin_amdgcn_s_waitcnt(0); asm volatile("" ::: "memory");
        int nkeys, b, r = 0, c = 0, r0 = 0, c0 = 0; const bool meta = R >= MREAL;
        if (meta) { b = (R - MREAL) >> 4; nkeys = 16; }
        else { b = R >> 11; const int s = R & 2047; r = s >> 6; c = s & 63; r0 = min(max(r - 4, 0), 24); c0 = min(max(c - 8, 0), 48); nkeys = 144; }
        float sc[3]; float mx = -3.0e38f;
#pragma unroll
        for (int it = 0; it < 3; ++it) {
            const int idx = it * 64 + lane; sc[it] = -3.0e38f;
            if (idx < nkeys) {
                int krow; float bias = 0.f;
                if (idx < 16) krow = MREAL + b * 16 + idx;
                else { const int i = (idx - 16) >> 4, j = (idx - 16) & 15; krow = b * 2048 + (r0 + i) * 64 + (c0 + j);
                       bias = rpb[(h * 15 + (r0 + i - r + 7)) * 31 + (c0 + j - c + 15)]; }
                sc[it] = dot128(qs, P + (size_t)krow * 8192 + 2048 + h * 128) * QSCALE + bias;
            }
            mx = fmaxf(mx, sc[it]);
        }
        mx = wave_max(mx);
        float sum = 0.f;
#pragma unroll
        for (int it = 0; it < 3; ++it) { const int idx = it * 64 + lane; float e = 0.f; if (idx < nkeys) e = __expf(sc[it] - mx); sum += e; if (idx < 192) ps[idx] = e; }
        sum = wave_sum(sum);
        __builtin_amdgcn_s_waitcnt(0); asm volatile("" ::: "memory");
        const float inv = 1.f / sum;
        float o0 = 0.f, o1 = 0.f;
        for (int idx = 0; idx < nkeys; ++idx) {
            int krow;
            if (idx < 16) krow = MREAL + b * 16 + idx;
            else { const int i = (idx - 16) >> 4, j = (idx - 16) & 15; krow = b * 2048 + (r0 + i) * 64 + (c0 + j); }
            const unsigned v = *(const unsigned*)(P + (size_t)krow * 8192 + 4096 + h * 128 + 2 * lane);
            const float pw = ps[idx];
            o0 += pw * __uint_as_float(v << 16); o1 += pw * __uint_as_float(v & 0xffff0000u);
        }
        const unsigned zz = *(const unsigned*)(P + (size_t)R * 8192 + 6144 + h * 128 + 2 * lane);
        const float y0 = o0 * inv * silu(__uint_as_float(zz << 16)), y1 = o1 * inv * silu(__uint_as_float(zz & 0xffff0000u));
        *(unsigned*)(Y + (size_t)R * DM + h * 128 + 2 * lane) = pk2(y0, y1);
        __builtin_amdgcn_s_waitcnt(0); asm volatile("" ::: "memory");
    }
}

__device__ __forceinline__ void phase_attn_diff(const Params& p, float* lds) {
    int tid = threadIdx.x; asm volatile("" : "+v"(tid)); const int lane = tid & 63, wave = tid >> 6;
    float* qs = lds + wave * 4352; float* as = qs + 128; float* tmp = as + 2112;
    const bf16_t* P = (const bf16_t*)(p.ws + WS_P); bf16_t* Y = (bf16_t*)(p.ws + WS_Y);
    const int gw = blockIdx.x * NWAVES + wave, NGW = gridDim.x * NWAVES;
    float l1 = 0.f, l2 = 0.f;
    { l1 = p.lq1[lane] * p.lk1[lane] + p.lq1[lane + 64] * p.lk1[lane + 64]; l2 = p.lq2[lane] * p.lk2[lane] + p.lq2[lane + 64] * p.lk2[lane + 64]; }
    const float lam = __expf(wave_sum(l1)) - __expf(wave_sum(l2)) + LAMBDA_INIT_L1;
    constexpr int LK = 2064, NIT = (LK + 63) / 64;
    for (int task = gw; task < MTOT * 8; task += NGW) {
        const int R = task >> 3, h = task & 7;
        const bool meta = R >= MREAL; const int b = meta ? (R - MREAL) >> 4 : R >> 11; const int s = R & 2047;
        const float slope = exp2f(-(float)(h + 1));
        for (int j = 0; j < 2; ++j) {
            const bf16_t* qrow = P + (size_t)R * 8192 + h * 256 + j * 128;
            __builtin_amdgcn_s_waitcnt(0); asm volatile("" ::: "memory");
            qs[lane] = bf2f(qrow[lane]); qs[lane + 64] = bf2f(qrow[lane + 64]);
            __builtin_amdgcn_s_waitcnt(0); asm volatile("" ::: "memory");
            float mx = -3.0e38f;
            for (int it = 0; it < NIT; ++it) {
                const int idx = it * 64 + lane; float sv = -3.0e38f;
                if (idx < LK) {
                    int krow; float bias = 0.f;
                    if (idx < 16) krow = MREAL + b * 16 + idx;
                    else { const int t = idx - 16; krow = b * 2048 + t; if (!meta) bias = -slope * fabsf((float)(s - t)); }
                    sv = dot128(qs, P + (size_t)krow * 8192 + 2048 + h * 256 + j * 128) * QSCALE + bias;
                }
                tmp[idx] = sv; mx = fmaxf(mx, sv);
            }
            mx = wave_max(mx);
            float sum = 0.f;
            for (int it = 0; it < NIT; ++it) { const int idx = it * 64 + lane; float e = 0.f; if (idx < LK) e = __expf(tmp[idx] - mx); tmp[idx] = e; sum += e; }
            sum = wave_sum(sum);
            const float inv = 1.f / sum;
            for (int it = 0; it < NIT; ++it) { const int idx = it * 64 + lane; if (j == 0) as[idx] = tmp[idx] * inv; else as[idx] -= lam * tmp[idx] * inv; }
        }
        __builtin_amdgcn_s_waitcnt(0); asm volatile("" ::: "memory");
        float o[4] = {0.f, 0.f, 0.f, 0.f};
        for (int idx = 0; idx < LK; ++idx) {
            const int krow = idx < 16 ? MREAL + b * 16 + idx : b * 2048 + idx - 16;
            const uint2 v = *(const uint2*)(P + (size_t)krow * 8192 + 4096 + h * 256 + 4 * lane);
            const float a = as[idx];
            o[0] += a * __uint_as_float(v.x << 16); o[1] += a * __uint_as_float(v.x & 0xffff0000u);
            o[2] += a * __uint_as_float(v.y << 16); o[3] += a * __uint_as_float(v.y & 0xffff0000u);
        }
        const float ss = wave_sum(o[0] * o[0] + o[1] * o[1] + o[2] * o[2] + o[3] * o[3]);
        const float rinv = 1.f / sqrtf(ss * (1.f / 256.f) + RMS_EPS) * (1.f - LAMBDA_INIT_L1);
        const f32x4 g = *(const f32x4*)(p.subg + 4 * lane);
        const uint2 zz = *(const uint2*)(P + (size_t)R * 8192 + 6144 + h * 256 + 4 * lane);
        const float y0 = o[0] * rinv * g[0] * silu(__uint_as_float(zz.x << 16)), y1 = o[1] * rinv * g[1] * silu(__uint_as_float(zz.x & 0xffff0000u));
        const float y2 = o[2] * rinv * g[2] * silu(__uint_as_float(zz.y << 16)), y3 = o[3] * rinv * g[3] * silu(__uint_as_float(zz.y & 0xffff0000u));
        uint2 ov; ov.x = pk2(y0, y1); ov.y = pk2(y2, y3);
        *(uint2*)(Y + (size_t)R * DM + h * 256 + 4 * lane) = ov;
    }
}

__device__ __forceinline__ void phase_attn_swa(const Params& p, float* lds) {
    int tid = threadIdx.x; asm volatile("" : "+v"(tid)); const int lane = tid & 63, wave = tid >> 6;
    float* qs = lds + wave * 512; float* ps = qs + 128;
    const bf16_t* P = (const bf16_t*)(p.ws + WS_P); bf16_t* Y = (bf16_t*)(p.ws + WS_Y);
    const int gw = blockIdx.x * NWAVES + wave, NGW = gridDim.x * NWAVES;
    constexpr int LDP = 5120;
    for (int task = gw; task < MTOT * 16; task += NGW) {
        const int R = task >> 4, hd = task & 15, kh = hd >> 2;
        const bf16_t* qrow = P + (size_t)R * LDP + hd * 128;
        qs[lane] = bf2f(qrow[lane]); qs[lane + 64] = bf2f(qrow[lane + 64]);
        __builtin_amdgcn_s_waitcnt(0); asm volatile("" ::: "memory");
        const bool meta = R >= MREAL; const int b = meta ? (R - MREAL) >> 4 : R >> 11; const int s = R & 2047;
        const int tlo = meta ? 0 : max(s - 128, 0), thi = meta ? -1 : min(s + 128, 2047);
        const int nkeys = 16 + (thi - tlo + 1);
        const float slope = exp2f(-0.5f * (float)(hd + 1)), sinkv = p.sink[hd];
        float sc[5]; float mx = sinkv;
#pragma unroll
        for (int it = 0; it < 5; ++it) {
            const int idx = it * 64 + lane; sc[it] = -3.0e38f;
            if (idx < nkeys) {
                int krow; float bias = 0.f;
                if (idx < 16) krow = MREAL + b * 16 + idx;
                else { const int t = tlo + idx - 16; krow = b * 2048 + t; bias = -slope * fabsf((float)(s - t)); }
                sc[it] = dot128(qs, P + (size_t)krow * LDP + 2048 + kh * 128) * QSCALE + bias;
            }
            mx = fmaxf(mx, sc[it]);
        }
        mx = wave_max(mx);
        float sum = 0.f;
#pragma unroll
        for (int it = 0; it < 5; ++it) { const int idx = it * 64 + lane; float e = 0.f; if (idx < nkeys) e = __expf(sc[it] - mx); sum += e; ps[idx] = e; }
        sum = wave_sum(sum) + __expf(sinkv - mx);
        __builtin_amdgcn_s_waitcnt(0); asm volatile("" ::: "memory");
        const float inv = 1.f / sum;
        float o0 = 0.f, o1 = 0.f;
        for (int idx = 0; idx < nkeys; ++idx) {
            const int krow = idx < 16 ? MREAL + b * 16 + idx : b * 2048 + tlo + idx - 16;
            const unsigned v = *(const unsigned*)(P + (size_t)krow * LDP + 2560 + kh * 128 + 2 * lane);
            const float pw = ps[idx];
            o0 += pw * __uint_as_float(v << 16); o1 += pw * __uint_as_float(v & 0xffff0000u);
        }
        const unsigned zz = *(const unsigned*)(P + (size_t)R * LDP + 3072 + hd * 128 + 2 * lane);
        const float y0 = o0 * inv * silu(__uint_as_float(zz << 16)), y1 = o1 * inv * silu(__uint_as_float(zz & 0xffff0000u));
        *(unsigned*)(Y + (size_t)R * DM + hd * 128 + 2 * lane) = pk2(y0, y1);
        __builtin_amdgcn_s_waitcnt(0); asm volatile("" ::: "memory");
    }
}

__device__ __forceinline__ void phase_ln(const Params& p, int layer, bool last, int nrows) {
    int tid = threadIdx.x; asm volatile("" : "+v"(tid)); const int lane = tid & 63, wave = tid >> 6;
    const int gw = blockIdx.x * NWAVES + wave, NGW = gridDim.x * NWAVES;
    const float* RES = (const float*)(p.ws + WS_H32); float* ST = (float*)(p.ws + WS_ST); bf16_t* HB = (bf16_t*)(p.ws + WS_HB);
    const float* g = p.ln_g + layer * DM; const float* bb = p.ln_b + layer * DM;
    constexpr int NR = 4;
    for (int R0 = gw; R0 < nrows; R0 += NR * NGW) {
        int Rr[NR]; bool ok[NR];
#pragma unroll
        for (int i = 0; i < NR; ++i) { Rr[i] = R0 + i * NGW; ok[i] = Rr[i] < nrows; if (!ok[i]) Rr[i] = R0; }
        f32x4 v[NR][8]; float mean[NR], rstd[NR];
#pragma unroll
        for (int i = 0; i < NR; ++i)
#pragma unroll
            for (int j = 0; j < 8; ++j) v[i][j] = *(const f32x4*)(RES + (size_t)Rr[i] * DM + j * 256 + lane * 4);
#pragma unroll
        for (int i = 0; i < NR; ++i) { float s = 0.f;
#pragma unroll
            for (int j = 0; j < 8; ++j) s += (v[i][j][0] + v[i][j][1]) + (v[i][j][2] + v[i][j][3]);
            mean[i] = wave_sum(s) * (1.f / DM); float q = 0.f;
#pragma unroll
            for (int j = 0; j < 8; ++j) { v[i][j] = v[i][j] - mean[i]; q += (v[i][j][0] * v[i][j][0] + v[i][j][1] * v[i][j][1]) + (v[i][j][2] * v[i][j][2] + v[i][j][3] * v[i][j][3]); }
            rstd[i] = 1.f / sqrtf(wave_sum(q) * (1.f / DM) + LN_EPS);
            if (!last && lane == 0 && ok[i]) { ST[2 * Rr[i]] = mean[i]; ST[2 * Rr[i] + 1] = rstd[i]; } }
#pragma unroll
        for (int j = 0; j < 8; ++j) {
            const int c = j * 256 + lane * 4;
            const f32x4 gg = *(const f32x4*)(g + c), bv = *(const f32x4*)(bb + c);
#pragma unroll
            for (int i = 0; i < NR; ++i) { const f32x4 o = v[i][j] * rstd[i] * gg + bv;
                if (ok[i]) { if (last) *(f32x4*)(p.out + (size_t)Rr[i] * DM + c) = o;
                             else { uint2 w; w.x = pk2(o[0], o[1]); w.y = pk2(o[2], o[3]); *(uint2*)(HB + (size_t)Rr[i] * DM + c) = w; } } }
        }
    }
}

namespace pg8 {
#define PG8_LAS __attribute__((address_space(3)))
typedef unsigned short bf16_t;
typedef short bf16x8 __attribute__((ext_vector_type(8)));
typedef float f32x4 __attribute__((ext_vector_type(4)));
typedef unsigned u32x4 __attribute__((ext_vector_type(4)));
constexpr int BM = 256, BK = 64, HALF = 128, HTB = HALF * BK * 2  , STAGE_BYTES = 8 * HTB, NXCD = 8, WGM = 8;

__host__ __device__ __forceinline__ int lds_byte(int r, int c) { const int st = (r >> 4) * 2 + (c >> 5), rr = r & 15, cc = c & 31, ob = rr * 64 + cc * 2; return st * 1024 + (ob ^ (((ob >> 9) & 1) << 5)); }
__host__ __device__ __forceinline__ void stage_rc(int b, int& R, int& C) { const int st = b / 1024, sb = b % 1024, swz = sb ^ (((sb >> 9) & 1) << 5); R = (st >> 1) * 16 + swz / 64; C = (st & 1) * 32 + (swz % 64) / 2; }
__host__ __device__ __forceinline__ int perm32(int rho) { const int n = rho >> 4, i = rho & 15; return 8 * (i >> 2) + 4 * n + (i & 3); }

struct Unit { int pm, pn; };
struct Gemm { const bf16_t* A; const bf16_t* Bt; int M, N, K; };

struct StaticOrder {
    int nM, nN, nwg, G, c;
    __host__ __device__ void init(int M, int N, int G_, int c_) { nM = M / BM; nN = N / BM; nwg = nM * nN; G = G_; c = c_; }
    __host__ __device__ bool next(int i, Unit& u) const {
        const long L = (long)i * G + c; if (L >= nwg) return false;
        int wgid = (int)L; { const int q = nwg / NXCD, r = nwg % NXCD, xcd = wgid % NXCD, off = wgid / NXCD; wgid = (xcd < r ? xcd * (q + 1) : r * (q + 1) + (xcd - r) * q) + off; }
        const int nig = WGM * nN, gid = wgid / nig, fm = gid * WGM, gsz = (nM - fm) < WGM ? (nM - fm) : WGM;
        u.pm = fm + ((wgid % nig) % gsz); u.pn = (wgid % nig) / gsz; return true;
    }
    __device__ __forceinline__ void a_ready(const Unit&) const {}
    __device__ __forceinline__ void done(const Unit&) const {}
};

typedef float f32x2c __attribute__((ext_vector_type(2))); typedef __bf16 bf16x2c __attribute__((ext_vector_type(2)));
__device__ __forceinline__ unsigned cvt_pk_bf16(float lo, float hi) { f32x2c v = {lo, hi}; bf16x2c b = __builtin_convertvector(v, bf16x2c); return __builtin_bit_cast(unsigned, b); }
typedef float f32x2 __attribute__((ext_vector_type(2)));

struct EpiBf16s {
    static constexpr bool PERM = true, AFTER_DRAIN = false;
    bf16_t* O; int ldc; int qcols; float qscale;
    __device__ __forceinline__ void operator()(const f32x4 (&acc)[2][2][4][2], const Unit& u, int wr, int wc, int fr, int fq) const {
        const int row0 = u.pm * BM + wr * 64 + fr, col0 = u.pn * BM + wc * 32 + 8 * fq; const float sc = (u.pn * BM < qcols) ? qscale : 1.f;
#pragma unroll
        for (int ai = 0; ai < 2; ++ai)
#pragma unroll
            for (int m = 0; m < 4; ++m) { bf16_t* rowp = O + (size_t)(row0 + ai * HALF + m * 16) * ldc + col0;
#pragma unroll
                for (int bj = 0; bj < 2; ++bj) { const f32x4 v0 = acc[ai][bj][m][0] * sc, v1 = acc[ai][bj][m][1] * sc;
                    u32x4 w; w.x = cvt_pk_bf16(v0[0], v0[1]); w.y = cvt_pk_bf16(v0[2], v0[3]); w.z = cvt_pk_bf16(v1[0], v1[1]); w.w = cvt_pk_bf16(v1[2], v1[3]);
                    *(u32x4*)(rowp + bj * HALF) = w; } }
    }
};
struct EpiResF32 {
    static constexpr bool PERM = false, AFTER_DRAIN = false;
    float* RES; const float* xin; const float* st; const float* g; const float* bvec; int ldc; float alpha;
    __device__ __forceinline__ void operator()(const f32x4 (&acc)[2][2][4][2], const Unit& u, int wr, int wc, int fr, int fq) const {
        typedef float f32x2v __attribute__((ext_vector_type(2)));
        const int row0 = u.pm * BM + wr * 64 + fr, col0 = u.pn * BM + wc * 32 + 4 * fq;
        f32x4 gq[2][2], bq[2][2];
#pragma unroll
        for (int bj = 0; bj < 2; ++bj)
#pragma unroll
            for (int n = 0; n < 2; ++n) { if (!xin) { gq[bj][n] = *(const f32x4*)(g + col0 + bj * HALF + n * 16); bq[bj][n] = *(const f32x4*)(bvec + col0 + bj * HALF + n * 16); }
                                          else { gq[bj][n] = (f32x4){1.f, 1.f, 1.f, 1.f}; bq[bj][n] = (f32x4){0.f, 0.f, 0.f, 0.f}; } }
#pragma unroll
        for (int ai = 0; ai < 2; ++ai)
#pragma unroll
            for (int m = 0; m < 4; ++m) { const int row = row0 + ai * HALF + m * 16; const size_t off = (size_t)row * ldc + col0;
                f32x2v sr = {0.f, 1.f}; if (!xin) sr = *(const f32x2v*)(st + 2 * row);
#pragma unroll
                for (int bj = 0; bj < 2; ++bj)
#pragma unroll
                    for (int n = 0; n < 2; ++n) { const size_t o2 = off + bj * HALF + n * 16;
                        f32x4 h;
                        if (xin) h = *(const f32x4*)(xin + o2); else h = (*(const f32x4*)(RES + o2) - sr.x) * sr.y * gq[bj][n] + bq[bj][n];
                        *(f32x4*)(RES + o2) = h * alpha + acc[ai][bj][m][n]; }
                if (m & 1) asm volatile("" ::: "memory"); }
    }
};

template <class Epi, class Sched, bool ALIGN_EPI = false, bool SP2 = false>
__device__ __forceinline__ void gemm_phase(PG8_LAS unsigned char* lds, const Gemm g, const Sched& S, const Epi& E) {
    int tid_ = threadIdx.x; asm volatile("" : "+v"(tid_));
    const int tid = tid_, wid = __builtin_amdgcn_readfirstlane(tid >> 6), lane = tid & 63, wr = wid >> 2, wc = wid & 3, fr = lane & 15, fq = lane >> 4;
    const int K = g.K, nt = K / BK;
    unsigned voffA[2], voffB[2];
#pragma unroll
    for (int i = 0; i < 2; ++i) { int R, C; stage_rc(tid * 16 + i * 8192, R, C); const int Rb = Epi::PERM ? ((R & ~31) + perm32(R & 31)) : R;
        voffA[i] = (unsigned)(R * K + C) * 2u; voffB[i] = (unsigned)(Rb * K + C) * 2u; }
    const size_t kstep = (size_t)(BK * 2);
    const size_t hstep = (size_t)HALF * K * 2;
    const size_t tstep = 2 * hstep;
    const unsigned ldsw = (unsigned)wid * 1024u;
    const int aoff = lds_byte(wr * 64 + fr, fq * 8), boff = lds_byte(wc * 32 + fr, fq * 8);
#define PG8_SA(b, h) (((b) * 2 + (h)) * HTB)
#define PG8_SB(b, h) ((4 + (b) * 2 + (h)) * HTB)
#define PG8_STAGE(bufoff, gbase, voff) do { _Pragma("unroll") for (int _i = 0; _i < 2; ++_i) \
        __builtin_amdgcn_global_load_lds((const unsigned*)((const char*)(gbase) + (voff)[_i]), (PG8_LAS unsigned*)(lds + (bufoff) + ldsw + _i * 8192), 16, 0, 0); } while (0)
#define PG8_LDA(dst, b, h) do { _Pragma("unroll") for (int m = 0; m < 4; ++m) _Pragma("unroll") for (int k = 0; k < 2; ++k) dst[m][k] = *(const PG8_LAS bf16x8*)(lds + PG8_SA(b, h) + aoff + m * 2048 + k * 1024); } while (0)
#define PG8_LDB(dst, b, h) do { _Pragma("unroll") for (int n = 0; n < 2; ++n) _Pragma("unroll") for (int k = 0; k < 2; ++k) dst[n][k] = *(const PG8_LAS bf16x8*)(lds + PG8_SB(b, h) + boff + n * 2048 + k * 1024); } while (0)
#define PG8_MMA(ai, bj, At, Bt) do { __builtin_amdgcn_s_setprio(1); _Pragma("unroll") for (int m = 0; m < 4; ++m) _Pragma("unroll") for (int n = 0; n < 2; ++n) _Pragma("unroll") for (int k = 0; k < 2; ++k) \
        acc[ai][bj][m][n] = __builtin_amdgcn_mfma_f32_16x16x32_bf16(Bt[n][k], At[m][k], acc[ai][bj][m][n], 0, 0, 0); __builtin_amdgcn_s_setprio(0); } while (0)
#define PG8_WAIT_V(n) asm volatile("s_waitcnt vmcnt(" #n ")" ::: "memory")
#define PG8_WAIT_L(n) asm volatile("s_waitcnt lgkmcnt(" #n ")" ::: "memory")
#define PG8_BAR __builtin_amdgcn_s_barrier()
#define PG8_SCHED __builtin_amdgcn_sched_barrier(0)
    Unit cur, nxt; int ui = 0;
    if (!S.next(0, cur)) return;
    f32x4 acc[2][2][4][2];
#pragma unroll
    for (int a = 0; a < 2; ++a)
#pragma unroll
        for (int b = 0; b < 2; ++b)
#pragma unroll
            for (int m = 0; m < 4; ++m)
#pragma unroll
                for (int n = 0; n < 2; ++n) acc[a][b][m][n] = (f32x4){0.f, 0.f, 0.f, 0.f};
    bf16x8 At[4][2], B0[2][2], B1[2][2];
    const char* cA = (const char*)g.A + (size_t)cur.pm * tstep; const char* cB = (const char*)g.Bt + (size_t)cur.pn * tstep;
    S.a_ready(cur);
    if constexpr (SP2) {
        PG8_STAGE(PG8_SB(0, 0), cB, voffB); PG8_STAGE(PG8_SB(0, 1), cB + hstep, voffB); PG8_STAGE(PG8_SA(0, 0), cA, voffA); PG8_STAGE(PG8_SA(0, 1), cA + hstep, voffA);
        if (wr == 1) PG8_BAR;
        PG8_WAIT_V(2); PG8_BAR;
        PG8_STAGE(PG8_SB(1, 0), cB + kstep, voffB); PG8_STAGE(PG8_SA(1, 0), cA + kstep, voffA); PG8_STAGE(PG8_SB(1, 1), cB + hstep + kstep, voffB);
        PG8_WAIT_V(6); PG8_BAR;
    } else {
        PG8_STAGE(PG8_SB(0, 0), cB, voffB); PG8_STAGE(PG8_SA(0, 0), cA, voffA); PG8_STAGE(PG8_SB(0, 1), cB + hstep, voffB); PG8_STAGE(PG8_SA(0, 1), cA + hstep, voffA);
        if (wr == 1) PG8_BAR;
        PG8_WAIT_V(4); PG8_BAR;
        PG8_STAGE(PG8_SB(1, 0), cB + kstep, voffB); PG8_STAGE(PG8_SA(1, 0), cA + kstep, voffA); PG8_STAGE(PG8_SB(1, 1), cB + hstep + kstep, voffB);
        PG8_WAIT_V(6); PG8_BAR;
    }
    for (;;) {
        const bool has_next = S.next(ui + 1, nxt);
        const char* nA = has_next ? (const char*)g.A + (size_t)nxt.pm * tstep : cA; const char* nB = has_next ? (const char*)g.Bt + (size_t)nxt.pn * tstep : cB;
        for (int t = 0; t < nt; t += 2) {
            const bool last = (t == nt - 2);
            const char* a1 = cA + (size_t)(t + 1) * kstep;
            const char* a2 = last ? nA : cA + (size_t)(t + 2) * kstep; const char* b2 = last ? nB : cB + (size_t)(t + 2) * kstep;
            const char* a3 = a2 + kstep; const char* b3 = b2 + kstep;
            if (last && has_next) S.a_ready(nxt);
            if constexpr (SP2) {
            PG8_LDB(B0, 0, 0); PG8_LDB(B1, 0, 1); PG8_SCHED; PG8_LDA(At, 0, 0); PG8_STAGE(PG8_SA(1, 1), a1 + hstep, voffA);
            PG8_WAIT_V(8); PG8_WAIT_L(0); PG8_BAR; PG8_MMA(0, 0, At, B0); PG8_MMA(0, 1, At, B1); PG8_BAR; PG8_SCHED;
            PG8_LDA(At, 0, 1); PG8_STAGE(PG8_SB(0, 0), b2, voffB); PG8_STAGE(PG8_SB(0, 1), b2 + hstep, voffB); PG8_STAGE(PG8_SA(0, 0), a2, voffA);
            PG8_WAIT_V(8); PG8_WAIT_L(0); PG8_BAR; PG8_MMA(1, 0, At, B0); PG8_MMA(1, 1, At, B1); PG8_BAR; PG8_SCHED;
            PG8_LDB(B0, 1, 0); PG8_LDB(B1, 1, 1); PG8_SCHED; PG8_LDA(At, 1, 0); PG8_STAGE(PG8_SA(0, 1), a2 + hstep, voffA);
            PG8_WAIT_V(8); PG8_WAIT_L(0); PG8_BAR; PG8_MMA(0, 0, At, B0); PG8_MMA(0, 1, At, B1); PG8_BAR; PG8_SCHED;
            PG8_LDA(At, 1, 1); PG8_STAGE(PG8_SB(1, 0), b3, voffB); PG8_STAGE(PG8_SB(1, 1), b3 + hstep, voffB); PG8_STAGE(PG8_SA(1, 0), a3, voffA);
            PG8_WAIT_V(8); PG8_WAIT_L(0); PG8_BAR; PG8_MMA(1, 0, At, B0); PG8_MMA(1, 1, At, B1); PG8_BAR; PG8_SCHED;
            } else {
            PG8_LDB(B0, 0, 0); PG8_SCHED; PG8_LDA(At, 0, 0); PG8_STAGE(PG8_SA(1, 1), a1 + hstep, voffA);
            PG8_WAIT_L(8); PG8_BAR; PG8_WAIT_L(0); PG8_MMA(0, 0, At, B0); PG8_BAR; PG8_SCHED;
            PG8_LDB(B1, 0, 1); PG8_STAGE(PG8_SB(0, 0), b2, voffB);
            PG8_BAR; PG8_WAIT_L(0); PG8_MMA(0, 1, At, B1); PG8_BAR;
            PG8_LDA(At, 0, 1); PG8_STAGE(PG8_SA(0, 0), a2, voffA);
            PG8_BAR; PG8_WAIT_L(0); PG8_MMA(1, 0, At, B0); PG8_BAR; PG8_SCHED;
            PG8_STAGE(PG8_SB(0, 1), b2 + hstep, voffB);
            PG8_WAIT_V(6); PG8_BAR; PG8_MMA(1, 1, At, B1); PG8_BAR;
            PG8_LDB(B0, 1, 0); PG8_SCHED; PG8_LDA(At, 1, 0); PG8_STAGE(PG8_SA(0, 1), a2 + hstep, voffA);
            PG8_WAIT_L(8); PG8_BAR; PG8_WAIT_L(0); PG8_MMA(0, 0, At, B0); PG8_BAR; PG8_SCHED;
            PG8_LDB(B1, 1, 1); PG8_STAGE(PG8_SB(1, 0), b3, voffB);
            PG8_BAR; PG8_WAIT_L(0); PG8_MMA(0, 1, At, B1); PG8_BAR;
            PG8_LDA(At, 1, 1); PG8_STAGE(PG8_SA(1, 0), a3, voffA);
            PG8_BAR; PG8_WAIT_L(0); PG8_MMA(1, 0, At, B0); PG8_BAR; PG8_SCHED;
            PG8_STAGE(PG8_SB(1, 1), b3 + hstep, voffB);
            PG8_WAIT_V(6); PG8_BAR; PG8_MMA(1, 1, At, B1); PG8_BAR;
            }
        }
        if constexpr (ALIGN_EPI) { if (wr == 0) PG8_BAR; }
        if constexpr (!Epi::AFTER_DRAIN) { E(acc, cur, wr, wc, fr, fq); S.done(cur); }
        if (!has_next) break;
#pragma unroll
        for (int a = 0; a < 2; ++a)
#pragma unroll
            for (int b = 0; b < 2; ++b)
#pragma unroll
                for (int m = 0; m < 4; ++m)
#pragma unroll
                    for (int n = 0; n < 2; ++n) acc[a][b][m][n] = (f32x4){0.f, 0.f, 0.f, 0.f};
        cur = nxt; cA = nA; cB = nB; ++ui;
        if constexpr (ALIGN_EPI) { if (wr == 1) PG8_BAR; }
    }
    PG8_WAIT_V(0);
    if constexpr (!ALIGN_EPI) { if (wr == 0) PG8_BAR; }
    PG8_BAR;
    if constexpr (Epi::AFTER_DRAIN) { E.fused(acc, cur, wr, wc, fr, fq, lds, wid, lane); S.done(cur); }
#undef PG8_SA
#undef PG8_SB
#undef PG8_STAGE
#undef PG8_LDA
#undef PG8_LDB
#undef PG8_MMA
#undef PG8_WAIT_V
#undef PG8_WAIT_L
#undef PG8_BAR
#undef PG8_SCHED
}
}


template <int MODE, int NCG>
__device__ __forceinline__ void phase_gemm_meta(const bf16_t* A, const bf16_t* Bt, int N, void* Cout, const float* H32, float* red, int first_block, const float* lng = nullptr, const float* lnb = nullptr) {
    typedef short bf16x8m __attribute__((ext_vector_type(8)));
    int tid = threadIdx.x; asm volatile("" : "+v"(tid)); const int lane = tid & 63, wave = tid >> 6, fr = lane & 15, fq = lane >> 4;
    const int ntask = N / (16 * NCG), G = gridDim.x, vb = ((int)blockIdx.x - first_block + G) % G;
    for (int g = vb; g < ntask; g += G) {
        const bf16_t* ap = A + (size_t)(MREAL + fr) * DM + wave * 256 + fq * 16;
        const bf16_t* bp = Bt + (size_t)(g * 16 * NCG + fr) * DM + wave * 256 + fq * 16;
        f32x4 acc[NCG][4];
#pragma unroll
        for (int c = 0; c < NCG; ++c)
#pragma unroll
            for (int rg = 0; rg < 4; ++rg) acc[c][rg] = (f32x4){0.f, 0.f, 0.f, 0.f};
#pragma unroll
        for (int s2 = 0; s2 < 4; ++s2) {
            bf16x8m af[4][2], bfr[NCG][2];
#pragma unroll
            for (int c = 0; c < NCG; ++c) { bfr[c][0] = *(const bf16x8m*)(bp + (size_t)c * 16 * DM + s2 * 64); bfr[c][1] = *(const bf16x8m*)(bp + (size_t)c * 16 * DM + s2 * 64 + 8); }
#pragma unroll
            for (int rg = 0; rg < 4; ++rg) { af[rg][0] = *(const bf16x8m*)(ap + (size_t)rg * 16 * DM + s2 * 64); af[rg][1] = *(const bf16x8m*)(ap + (size_t)rg * 16 * DM + s2 * 64 + 8); }
#pragma unroll
            for (int c = 0; c < NCG; ++c)
#pragma unroll
                for (int rg = 0; rg < 4; ++rg) { acc[c][rg] = __builtin_amdgcn_mfma_f32_16x16x32_bf16(af[rg][0], bfr[c][0], acc[c][rg], 0, 0, 0); acc[c][rg] = __builtin_amdgcn_mfma_f32_16x16x32_bf16(af[rg][1], bfr[c][1], acc[c][rg], 0, 0, 0); }
        }
#pragma unroll
        for (int c = 0; c < NCG; ++c)
#pragma unroll
            for (int rg = 0; rg < 4; ++rg)
#pragma unroll
                for (int j = 0; j < 4; ++j) red[(wave * NCG + c) * 1024 + (rg * 4 + j) * 64 + lane] = acc[c][rg][j];
        __syncthreads();
#pragma unroll
        for (int h = 0; h < 2 * NCG; ++h) { const int e = tid + 512 * h, c = e >> 10, e1 = e & 1023, rgj = e1 >> 6, ln = e1 & 63; float v = 0.f;
#pragma unroll
            for (int w = 0; w < 8; ++w) v += red[(w * NCG + c) * 1024 + e1];
            const int R = MREAL + (rgj >> 2) * 16 + (ln >> 4) * 4 + (rgj & 3), col = (g * NCG + c) * 16 + (ln & 15);
            if (MODE == 0) ((bf16_t*)Cout)[(size_t)R * N + col] = (bf16_t)f2bf(col < 2048 ? v * QPRE : v);
            else { float* RES = (float*)Cout; float h = RES[(size_t)R * DM + col];
                if (H32) { const float* st = H32; h = (h - st[2 * R]) * st[2 * R + 1] * lng[col] + lnb[col]; }
                RES[(size_t)R * DM + col] = ALPHA * h + v; } }
        __syncthreads();
    }
}

namespace att {
typedef short bf16x8 __attribute__((ext_vector_type(8)));
typedef short s16x4 __attribute__((ext_vector_type(4)));
typedef float f32x16 __attribute__((ext_vector_type(16)));
typedef unsigned u32x4 __attribute__((ext_vector_type(4)));
constexpr int SHM_V = 16384, SHM_K = 16384, LDS_WS = 2 * SHM_V + 2 * SHM_K, LDS_TBL = LDS_WS + 8 * 64 * 4, LDS_Q = LDS_TBL + 15 * 128 * 4, LDS_BYTES = LDS_Q + 8 * 8192;
constexpr float NEG = -1e30f;
constexpr float THR2 = 8.f;
#define ATT_KSWZ(row, colB) ((row) * 256 + ((colB) ^ (((row) & 7) << 4)))
#define ATT_SBAR() __builtin_amdgcn_sched_barrier(0)
__device__ __forceinline__ constexpr int crow_c(int r) { return (r & 3) + 8 * (r >> 2); }
__device__ __forceinline__ int crow(int r, int hi) { return crow_c(r) + 4 * hi; }
typedef float f32x2_t __attribute__((ext_vector_type(2))); typedef __bf16 bf16x2_t __attribute__((ext_vector_type(2)));
__device__ __forceinline__ unsigned cvtpk(float lo, float hi) { f32x2_t v = {lo, hi}; bf16x2_t b = __builtin_convertvector(v, bf16x2_t); return __builtin_bit_cast(unsigned, b); }

__device__ __forceinline__ void partialSM(f32x16& p0, f32x16& p1, float& m_reg, float& alpha) {
  float pmax = p0[0];
#pragma unroll
  for (int r = 1; r < 16; ++r) pmax = fmaxf(pmax, p0[r]);
#pragma unroll
  for (int r = 0; r < 16; ++r) pmax = fmaxf(pmax, p1[r]);
  { auto rr = __builtin_amdgcn_permlane32_swap(__float_as_uint(pmax), __float_as_uint(pmax), false, false);
    pmax = fmaxf(__uint_as_float(rr[0]), __uint_as_float(rr[1])); }
  float mn;
  if (__builtin_expect(__all(pmax <= m_reg + THR2), 1)) { mn = m_reg; alpha = 1.f; }
  else { mn = fmaxf(m_reg, pmax); alpha = __builtin_amdgcn_exp2f(m_reg - mn); m_reg = mn; }
#pragma unroll
  for (int r = 0; r < 16; ++r) { p0[r] = __builtin_amdgcn_exp2f(p0[r] - mn); p1[r] = p1[r] - mn; }
}
__device__ __forceinline__ void finishSM(f32x16& p0, f32x16& p1, float alpha, float& l_reg, bf16x8& pa0, bf16x8& pa1, bf16x8& pa2, bf16x8& pa3) {
#pragma unroll
  for (int r = 0; r < 16; ++r) p1[r] = __builtin_amdgcn_exp2f(p1[r]);
  float ps = 0;
#pragma unroll
  for (int r = 0; r < 16; ++r) ps += p0[r];
#pragma unroll
  for (int r = 0; r < 16; ++r) ps += p1[r];
  { auto rr = __builtin_amdgcn_permlane32_swap(__float_as_uint(ps), __float_as_uint(ps), false, false);
    ps = __uint_as_float(rr[0]) + __uint_as_float(rr[1]); }
  l_reg = l_reg * alpha + ps;
#define ATT_PK4(P, BASE, OUT) do { unsigned a0 = cvtpk(P[BASE + 0], P[BASE + 1]), a1 = cvtpk(P[BASE + 2], P[BASE + 3]);   \
    unsigned b0 = cvtpk(P[BASE + 4], P[BASE + 5]), b1 = cvtpk(P[BASE + 6], P[BASE + 7]);                              \
    auto r0 = __builtin_amdgcn_permlane32_swap(a0, b0, false, false); auto r1 = __builtin_amdgcn_permlane32_swap(a1, b1, false, false); \
    u32x4 w = {r0[0], r1[0], r0[1], r1[1]}; OUT = *reinterpret_cast<bf16x8*>(&w); } while (0)
  ATT_PK4(p0, 0, pa0); ATT_PK4(p0, 8, pa1); ATT_PK4(p1, 0, pa2); ATT_PK4(p1, 8, pa3);
#undef ATT_PK4
}
template <bool QREG>
__device__ __forceinline__ void qkt(f32x16& p0, f32x16& p1, const char* Ks, const char* qr, const bf16x8* qreg, int r32, int hi) {
  p0 = f32x16{}; p1 = f32x16{};
#pragma unroll
  for (int d0 = 0; d0 < 8; ++d0) { const int cb = (d0 * 16 + hi * 8) * 2;
    const bf16x8 b0 = *reinterpret_cast<const bf16x8*>(Ks + ATT_KSWZ(r32, cb));
    const bf16x8 b1 = *reinterpret_cast<const bf16x8*>(Ks + ATT_KSWZ(32 + r32, cb));
    bf16x8 qf; if constexpr (QREG) qf = qreg[d0]; else qf = *reinterpret_cast<const bf16x8*>(qr + d0 * 1024);
    p0 = __builtin_amdgcn_mfma_f32_32x32x16_bf16(b0, qf, p0, 0, 0, 0);
    p1 = __builtin_amdgcn_mfma_f32_32x32x16_bf16(b1, qf, p1, 0, 0, 0); }
}
__device__ __forceinline__ int v_st(int k, int c) { const int kk = (k & ~0xC) | ((k & 4) << 1) | ((k & 8) >> 1); return ((kk >> 3) * 4 + (c >> 5)) * 512 + ((kk & 7) * 32 + (c & 31)) * 2; }
__device__ __forceinline__ int v_rd_base(int lane) { return ((lane & 3) << 3) | (((lane >> 2) & 3) << 6) | (((lane >> 4) & 1) << 5) | (((lane >> 5) & 1) << 8); }
constexpr int v_rd_off(int d0, int ks, int half) { return d0 * 512 + ks * 4096 + half * 2048; }
typedef short v4i16_t __attribute__((ext_vector_type(4)));
typedef __attribute__((address_space(3))) const char* lds_cptr;
template <int OFF> __device__ __forceinline__ s16x4 tr_read(lds_cptr vb) {
  return __builtin_bit_cast(s16x4, __builtin_amdgcn_ds_read_tr16_b64_v4i16((__attribute__((address_space(3))) v4i16_t*)(vb + OFF)));
}
template <int D0> __device__ __forceinline__ void pv_one(f32x16& od, lds_cptr vb, bf16x8 pa0, bf16x8 pa1, bf16x8 pa2, bf16x8 pa3) {
  const s16x4 l0 = tr_read<v_rd_off(D0, 0, 0)>(vb), h0 = tr_read<v_rd_off(D0, 0, 1)>(vb), l1 = tr_read<v_rd_off(D0, 1, 0)>(vb), h1 = tr_read<v_rd_off(D0, 1, 1)>(vb);
  const s16x4 l2 = tr_read<v_rd_off(D0, 2, 0)>(vb), h2 = tr_read<v_rd_off(D0, 2, 1)>(vb), l3 = tr_read<v_rd_off(D0, 3, 0)>(vb), h3 = tr_read<v_rd_off(D0, 3, 1)>(vb);
#define ATT_PK(L, H) (bf16x8){L[0], L[1], L[2], L[3], H[0], H[1], H[2], H[3]}
  od = __builtin_amdgcn_mfma_f32_32x32x16_bf16(pa0, ATT_PK(l0, h0), od, 0, 0, 0);
  od = __builtin_amdgcn_mfma_f32_32x32x16_bf16(pa1, ATT_PK(l1, h1), od, 0, 0, 0);
  od = __builtin_amdgcn_mfma_f32_32x32x16_bf16(pa2, ATT_PK(l2, h2), od, 0, 0, 0);
  od = __builtin_amdgcn_mfma_f32_32x32x16_bf16(pa3, ATT_PK(l3, h3), od, 0, 0, 0);
#undef ATT_PK
}
__device__ __forceinline__ void pv_d0(f32x16* o, lds_cptr vb, bf16x8 pa0, bf16x8 pa1, bf16x8 pa2, bf16x8 pa3) {
  pv_one<0>(o[0], vb, pa0, pa1, pa2, pa3); pv_one<1>(o[1], vb, pa0, pa1, pa2, pa3); pv_one<2>(o[2], vb, pa0, pa1, pa2, pa3); pv_one<3>(o[3], vb, pa0, pa1, pa2, pa3);
}

#define ATT_PROLOGUE_DECLS \
  const int lane = tid & 63, wid = __builtin_amdgcn_readfirstlane(tid >> 6), r32 = lane & 31, hi = lane >> 5; \
  char* V_lds = lds; char* K_lds = lds + 2 * SHM_V; \
  float* ws = (float*)(lds + LDS_WS) + wid * 64; float* li_l = ws; float* al_l = ws + 32; \
  float m_reg = NEG, l_reg = 0.f; f32x16 o[4] = {}; bf16x8 qreg[8]; char* const qr = lds + LDS_Q + wid * 8192 + lane * 16;     \
  { const bf16_t* Qw = U.qptr(wid, r32) + hi * 8; \
    _Pragma("unroll") for (int d0 = 0; d0 < 8; ++d0) { const bf16x8 qv_ = *reinterpret_cast<const bf16x8*>(Qw + d0 * 16); if constexpr (QREG) qreg[d0] = qv_; else *reinterpret_cast<bf16x8*>(qr + d0 * 1024) = qv_; } } \
  const typename UT::Lane L = U.lane_init(wid, r32, hi); \
  const int sr = tid >> 4, sc = (tid & 15) * 8, vst0 = v_st(sr, sc), vst1 = v_st(32 + sr, sc); \
  const lds_cptr vb0 = (lds_cptr)V_lds + v_rd_base(lane); \
  struct { bf16x8 vs0, vs1, ks0, ks1; } sr_[2]; \
  const int NT = U.NT;
#define ATT_SLOAD(i, t) do { const size_t ra_ = (size_t)U.krow((t), sr) * U.ldp + sc, rb_ = (size_t)U.krow((t), 32 + sr) * U.ldp + sc; \
    sr_[i].vs0 = *reinterpret_cast<const bf16x8*>(U.vbase + ra_); sr_[i].vs1 = *reinterpret_cast<const bf16x8*>(U.vbase + rb_); \
    sr_[i].ks0 = *reinterpret_cast<const bf16x8*>(U.kbase + ra_); sr_[i].ks1 = *reinterpret_cast<const bf16x8*>(U.kbase + rb_); } while (0)
#define ATT_SWRITE(b, i) do { *(bf16x8*)(V_lds + (b) * SHM_V + vst0) = sr_[i].vs0; *(bf16x8*)(V_lds + (b) * SHM_V + vst1) = sr_[i].vs1; const int kc_ = sc * 2; \
    *(bf16x8*)(K_lds + (b) * SHM_K + ATT_KSWZ(sr, kc_)) = sr_[i].ks0; *(bf16x8*)(K_lds + (b) * SHM_K + ATT_KSWZ(32 + sr, kc_)) = sr_[i].ks1; } while (0)
#define ATT_SWAIT() asm volatile("s_waitcnt vmcnt(4)" ::: "memory")
#define ATT_RESC(a) do { if (__any((a) < 1.f)) { if (hi == 0) al_l[r32] = (a); asm volatile("s_waitcnt lgkmcnt(0)" ::: "memory"); \
    _Pragma("unroll") for (int d = 0; d < 4; ++d) _Pragma("unroll") for (int r = 0; r < 16; ++r) o[d][r] *= al_l[crow(r, hi)]; } } while (0)
#define ATT_EPILOGUE \
  l_reg = U.final_l(l_reg, m_reg, wid); \
  if (hi == 0) li_l[r32] = l_reg; asm volatile("s_waitcnt lgkmcnt(0)" ::: "memory"); \
  { float* stg = (float*)(lds + LDS_Q + wid * 8192); \
    _Pragma("unroll") for (int half = 0; half < 2; ++half) { \
      _Pragma("unroll") for (int r8 = 0; r8 < 8; ++r8) { const int r = half * 8 + r8, orow = crow(r, hi); const float rl = __builtin_amdgcn_rcpf(li_l[orow]); \
        _Pragma("unroll") for (int d0 = 0; d0 < 4; ++d0) stg[(orow & 15) * 128 + d0 * 32 + r32] = o[d0][r] * rl; } \
      _Pragma("unroll") for (int i = 0; i < 4; ++i) { const int row16 = i * 4 + (lane >> 4), c8 = (lane & 15) * 8, orow = half * 16 + row16; \
        const f32x4 va = *(const f32x4*)(stg + row16 * 128 + c8), vb = *(const f32x4*)(stg + row16 * 128 + c8 + 4); \
        if (U.row_valid(wid, orow)) U.emit8(wid, orow, c8, va, vb); } } } \
  __syncthreads();

template <class UT, int SD, bool QREG = false>
__device__ __forceinline__ void attn_unit(const UT& U, char* lds, int tid) {
  ATT_PROLOGUE_DECLS
  constexpr int SE = 0, SO = SD - 1;
  U.prep(lds, tid);
  f32x16 pA0, pA1, pB0, pB1; float alA = 1.f, alB = 1.f; bf16x8 pa0, pa1, pa2, pa3;
#define ATT_SWAITD() do { if constexpr (SD == 2) asm volatile("s_waitcnt vmcnt(4)" ::: "memory"); else asm volatile("s_waitcnt vmcnt(0)" ::: "memory"); } while (0)
  ATT_SLOAD(SE, 0); asm volatile("s_waitcnt vmcnt(0)" ::: "memory"); ATT_SWRITE(0, SE); __syncthreads();
  qkt<QREG>(pA0, pA1, K_lds, qr, qreg, r32, hi); U.bias(L, pA0, pA1, 0, hi); partialSM(pA0, pA1, m_reg, alA);
  ATT_SLOAD(SO, 1); if constexpr (SD == 2) { if (2 < NT) ATT_SLOAD(SE, 2); }
  ATT_SWAITD(); ATT_SWRITE(1, SO); __syncthreads();
  for (int j = 1; j + 1 < NT; j += 2) {
    ATT_SBAR(); qkt<QREG>(pB0, pB1, K_lds + SHM_K, qr, qreg, r32, hi);
    finishSM(pA0, pA1, alA, l_reg, pa0, pa1, pa2, pa3); ATT_SBAR();
    if (j + SD < NT) ATT_SLOAD(SO, j + SD); ATT_SBAR();
    pv_d0(o, vb0, pa0, pa1, pa2, pa3);
    U.bias(L, pB0, pB1, j, hi); partialSM(pB0, pB1, m_reg, alB);
    __syncthreads(); ATT_SWAITD(); ATT_SWRITE(0, SE);
    ATT_RESC(alB); __syncthreads();
    ATT_SBAR(); qkt<QREG>(pA0, pA1, K_lds, qr, qreg, r32, hi);
    finishSM(pB0, pB1, alB, l_reg, pa0, pa1, pa2, pa3); ATT_SBAR();
    if (j + 1 + SD < NT) ATT_SLOAD(SE, j + 1 + SD); ATT_SBAR();
    pv_d0(o, vb0 + SHM_V, pa0, pa1, pa2, pa3);
    U.bias(L, pA0, pA1, j + 1, hi); partialSM(pA0, pA1, m_reg, alA);
    __syncthreads(); ATT_SWAITD(); if (j + 2 < NT) ATT_SWRITE(1, SO);
    ATT_RESC(alA); __syncthreads();
  }
  if ((NT & 1) == 0) {
    ATT_SBAR(); qkt<QREG>(pB0, pB1, K_lds + SHM_K, qr, qreg, r32, hi);
    finishSM(pA0, pA1, alA, l_reg, pa0, pa1, pa2, pa3); ATT_SBAR(); pv_d0(o, vb0, pa0, pa1, pa2, pa3);
    U.bias(L, pB0, pB1, NT - 1, hi); partialSM(pB0, pB1, m_reg, alB);
    ATT_RESC(alB);
    finishSM(pB0, pB1, alB, l_reg, pa0, pa1, pa2, pa3); ATT_SBAR(); pv_d0(o, vb0 + SHM_V, pa0, pa1, pa2, pa3);
  } else {
    finishSM(pA0, pA1, alA, l_reg, pa0, pa1, pa2, pa3); ATT_SBAR(); pv_d0(o, vb0, pa0, pa1, pa2, pa3);
  }
#undef ATT_SWAITD
  ATT_EPILOGUE
}

template <class UT, bool QREG = false>
__device__ __forceinline__ void attn_unit_skip(const UT& U, char* lds, int tid) {
  ATT_PROLOGUE_DECLS
  U.prep(lds, tid);
  f32x16 p0, p1; float al; bf16x8 pa0, pa1, pa2, pa3;
#define ATT_COMPUTE(buf) do { qkt<QREG>(p0, p1, K_lds + (buf) * SHM_K, qr, qreg, r32, hi); U.bias(L, p0, p1, tcur, hi); partialSM(p0, p1, m_reg, al); ATT_RESC(al); \
    finishSM(p0, p1, al, l_reg, pa0, pa1, pa2, pa3); ATT_SBAR(); pv_d0(o, vb0 + (buf) * SHM_V, pa0, pa1, pa2, pa3); } while (0)
  ATT_SLOAD(0, 0); asm volatile("s_waitcnt vmcnt(0)" ::: "memory"); ATT_SWRITE(0, 0); if (1 < NT) ATT_SLOAD(1, 1); __syncthreads();
  for (int t = 0; t < NT; t += 2) {
    { const int tcur = t; if (U.active(wid, tcur)) ATT_COMPUTE(0); }
    if (t + 1 < NT) ATT_SWRITE(1, 1);
    if (t + 2 < NT) ATT_SLOAD(0, t + 2);
    __syncthreads();
    if (t + 1 < NT) {
      { const int tcur = t + 1; if (U.active(wid, tcur)) ATT_COMPUTE(1); }
      if (t + 2 < NT) ATT_SWRITE(0, 0);
      if (t + 3 < NT) ATT_SLOAD(1, t + 3);
      __syncthreads();
    }
  }
#undef ATT_COMPUTE
  ATT_EPILOGUE
}

template <class UT, bool QREG = false>
__device__ __forceinline__ void attn_unit_splitk(const UT& U, char* lds, int tid) {
  ATT_PROLOGUE_DECLS
  U.prep(lds, tid);
  f32x16 p0, p1; float al; bf16x8 pa0, pa1, pa2, pa3;
#define ATT_COMPUTE(buf) do { qkt<QREG>(p0, p1, K_lds + (buf) * SHM_K, qr, qreg, r32, hi); U.bias(L, p0, p1, tcur, hi); partialSM(p0, p1, m_reg, al); ATT_RESC(al); \
    finishSM(p0, p1, al, l_reg, pa0, pa1, pa2, pa3); ATT_SBAR(); pv_d0(o, vb0 + (buf) * SHM_V, pa0, pa1, pa2, pa3); } while (0)
  ATT_SLOAD(0, 0); asm volatile("s_waitcnt vmcnt(0)" ::: "memory"); ATT_SWRITE(0, 0); if (1 < NT) ATT_SLOAD(1, 1); __syncthreads();
  for (int t = 0; t < NT; t += 2) {
    { const int tcur = t; if ((tcur & 7) == wid) ATT_COMPUTE(0); }
    if (t + 1 < NT) ATT_SWRITE(1, 1);
    if (t + 2 < NT) ATT_SLOAD(0, t + 2);
    __syncthreads();
    if (t + 1 < NT) {
      { const int tcur = t + 1; if ((tcur & 7) == wid) ATT_COMPUTE(1); }
      if (t + 2 < NT) ATT_SWRITE(0, 0);
      if (t + 3 < NT) ATT_SLOAD(1, t + 3);
      __syncthreads();
    }
  }
#undef ATT_COMPUTE
  float* wsall = (float*)(lds + LDS_WS);
  if (hi == 0) { li_l[r32] = m_reg; al_l[r32] = l_reg; }
  __syncthreads();
  float M = NEG;
#pragma unroll
  for (int w = 0; w < 8; ++w) M = fmaxf(M, wsall[w * 64 + r32]);
  const float fown = __builtin_amdgcn_exp2f(m_reg - M);
  __syncthreads();
  if (hi == 0) li_l[r32] = fown;
  asm volatile("s_waitcnt lgkmcnt(0)" ::: "memory");
  float* osum = (float*)lds;
#pragma unroll
  for (int r = 0; r < 8; ++r) { const int orow = crow(r, hi); const float f = li_l[orow];
#pragma unroll
    for (int d0 = 0; d0 < 4; ++d0) osum[(wid * 16 + orow) * 128 + d0 * 32 + r32] = o[d0][r] * f; }
  __syncthreads();
  { const int row = tid >> 5, c4 = (tid & 31) * 4;
    f32x4 acc = {0.f, 0.f, 0.f, 0.f}; float Lt = 0.f;
#pragma unroll
    for (int w = 0; w < 8; ++w) { acc += *(const f32x4*)(osum + (w * 16 + row) * 128 + c4); Lt += wsall[w * 64 + 32 + row] * wsall[w * 64 + row]; }
    const float rl = 1.f / Lt;
    U.emit4(row, c4, acc * rl); }
  __syncthreads();
}

template <bool META> struct DiffUnitT {
  static constexpr bool meta = META;
  struct Lane { float dq, sl; };
  const bf16_t *P, *kbase, *vbase; bf16_t* OD; int ldp, NT, b, h, j, half, qb;
  __device__ __forceinline__ void init(const unsigned char* ws, int i) {
    P = (const bf16_t*)(ws + WS_P); OD = (bf16_t*)(ws + WS_OD); ldp = 8192; NT = 33;
    int m = meta ? i - 1024 : i >> 3; qb = meta ? 0 : i & 7; half = m & 1; j = (m >> 1) & 1; h = (m >> 2) & 7; b = m >> 5;
    kbase = P + 2048 + h * 256 + j * 128; vbase = P + 4096 + h * 256 + half * 128;
  }
  __device__ __forceinline__ int qrow(int wid, int r) const { return meta ? MREAL + b * 16 + (r & 15) : b * 2048 + qb * 256 + wid * 32 + r; }
  __device__ __forceinline__ const bf16_t* qptr(int wid, int r32) const { return P + (size_t)qrow(wid, r32) * 8192 + h * 256 + j * 128; }
  __device__ __forceinline__ int krow(int t, int i) const { return t < 32 ? b * 2048 + t * 64 + i : MREAL + b * 16 + (i & 15); }
  __device__ __forceinline__ bool active(int wid, int t) const { return !meta || wid == 0; }
  __device__ __forceinline__ Lane lane_init(int wid, int r32, int hi) const {
    Lane L; L.dq = (float)(qb * 256 + wid * 32 + r32 - 4 * hi); L.sl = meta ? 0.f : exp2f(-(float)(h + 1)) * 1.4426950408889634f; return L; }
  __device__ __forceinline__ void bias(const Lane& L, f32x16& p0, f32x16& p1, int t, int hi) const {
    if (t < 32) { const float base = L.dq - 64.f * (float)t;
#pragma unroll
      for (int r = 0; r < 16; ++r) { p0[r] = fmaf(-L.sl, fabsf(base - (float)crow_c(r)), p0[r]); p1[r] = fmaf(-L.sl, fabsf(base - (float)(crow_c(r) + 32)), p1[r]); } }
    else {
#pragma unroll
      for (int r = 0; r < 16; ++r) { if (r >= 8) p0[r] = NEG; p1[r] = NEG; } }
  }
  __device__ __forceinline__ void prep(char* lds, int tid) const {}
  __device__ __forceinline__ float final_l(float l, float m, int wid) const { return l; }
  __device__ __forceinline__ bool row_valid(int wid, int orow) const { return !meta || (wid == 0 && orow < 16); }
  __device__ __forceinline__ void emit(int wid, int orow, int col, float v) const {
    OD[(size_t)qrow(wid, orow) * 4096 + h * 512 + j * 256 + half * 128 + col] = (bf16_t)f2bf(v); }
  __device__ __forceinline__ void emit8(int wid, int orow, int col, f32x4 a, f32x4 c) const {
    u32x4 w; w.x = pk2(a[0], a[1]); w.y = pk2(a[2], a[3]); w.z = pk2(c[0], c[1]); w.w = pk2(c[2], c[3]);
    *(u32x4*)(OD + (size_t)qrow(wid, orow) * 4096 + h * 512 + j * 256 + half * 128 + col) = w; }
  __device__ __forceinline__ void emit4(int row, int col, f32x4 v) const {
    uint2 w; w.x = pk2(v[0], v[1]); w.y = pk2(v[2], v[3]); *(uint2*)(OD + (size_t)(MREAL + b * 16 + row) * 4096 + h * 512 + j * 256 + half * 128 + col) = w; }
};

template <bool META> struct SwaUnitT {
  static constexpr bool meta = META;
  struct Lane { float dq, sl, lo, hi_; };
  const bf16_t *P, *kbase, *vbase; bf16_t* Y; const float* sink; int ldp, NT, b, kvh, s0;
  __device__ __forceinline__ void init(const Params& p, int i) {
    P = (const bf16_t*)(p.ws + WS_P); Y = (bf16_t*)(p.ws + WS_Y); sink = p.sink; ldp = 5120; NT = meta ? 1 : 6;
    const int m = meta ? i : i >> 5; s0 = meta ? 0 : (i & 31) * 64; kvh = m & 3; b = m >> 2;
    kbase = P + 2048 + kvh * 128; vbase = P + 2560 + kvh * 128;
  }
  __device__ __forceinline__ int head(int wid) const { return kvh * 4 + (meta ? (wid & 3) : (wid >> 1)); }
  __device__ __forceinline__ int qrow(int wid, int r) const { return meta ? MREAL + b * 16 + (r & 15) : b * 2048 + s0 + 32 * (wid & 1) + r; }
  __device__ __forceinline__ const bf16_t* qptr(int wid, int r32) const { return P + (size_t)qrow(wid, r32) * 5120 + head(wid) * 128; }
  __device__ __forceinline__ int krow(int t, int i) const {
    if (meta || t == 5) return MREAL + b * 16 + (i & 15);
    const int kp = s0 - 128 + 64 * t + i; return b * 2048 + min(max(kp, 0), 2047); }
  __device__ __forceinline__ bool active(int wid, int t) const { return !meta || wid < 4; }
  __device__ __forceinline__ void prep(char* lds, int tid) const {}
  __device__ __forceinline__ Lane lane_init(int wid, int r32, int hi) const {
    Lane L; const int s = s0 + 32 * (wid & 1) + r32;
    L.dq = (float)(32 * (wid & 1) + r32 + 128 - 4 * hi);
    L.sl = exp2f(-0.5f * (float)(head(wid) + 1)) * 1.4426950408889634f;
    L.lo = (float)max(-128, s - 2047); L.hi_ = (float)min(128, s); return L; }
  __device__ __forceinline__ void bias(const Lane& L, f32x16& p0, f32x16& p1, int t, int hi) const {
    if (!meta && t < 5) { const float base = L.dq - 64.f * (float)t;
#pragma unroll
      for (int r = 0; r < 16; ++r) { const float x0 = base - (float)crow_c(r), x1 = base - (float)(crow_c(r) + 32);
        p0[r] = (x0 >= L.lo && x0 <= L.hi_) ? fmaf(-L.sl, fabsf(x0), p0[r]) : NEG;
        p1[r] = (x1 >= L.lo && x1 <= L.hi_) ? fmaf(-L.sl, fabsf(x1), p1[r]) : NEG; } }
    else {
#pragma unroll
      for (int r = 0; r < 16; ++r) { if (r >= 8) p0[r] = NEG; p1[r] = NEG; } }
  }
  __device__ __forceinline__ float final_l(float l, float m, int wid) const { return l + __builtin_amdgcn_exp2f(sink[head(wid)] * 1.4426950408889634f - m); }
  __device__ __forceinline__ bool row_valid(int wid, int orow) const { return !meta || (wid < 4 && orow < 16); }
  __device__ __forceinline__ void emit(int wid, int orow, int col, float v) const {
    const int R = qrow(wid, orow), hd = head(wid); const float z = bf2f(P[(size_t)R * 5120 + 3072 + hd * 128 + col]);
    Y[(size_t)R * DM + hd * 128 + col] = (bf16_t)f2bf(v * silu(z)); }
  __device__ __forceinline__ void emit8(int wid, int orow, int col, f32x4 a, f32x4 c) const {
    const int R = qrow(wid, orow), hd = head(wid); const u32x4 z = *(const u32x4*)(P + (size_t)R * 5120 + 3072 + hd * 128 + col); u32x4 w;
    w.x = pk2(a[0] * silu(__uint_as_float(z.x << 16)), a[1] * silu(__uint_as_float(z.x & 0xffff0000u))); w.y = pk2(a[2] * silu(__uint_as_float(z.y << 16)), a[3] * silu(__uint_as_float(z.y & 0xffff0000u)));
    w.z = pk2(c[0] * silu(__uint_as_float(z.z << 16)), c[1] * silu(__uint_as_float(z.z & 0xffff0000u))); w.w = pk2(c[2] * silu(__uint_as_float(z.w << 16)), c[3] * silu(__uint_as_float(z.w & 0xffff0000u)));
    *(u32x4*)(Y + (size_t)R * DM + hd * 128 + col) = w; }
};

template <bool META> struct NaUnitT {
  static constexpr bool meta = META;
  struct Lane { const float* tb; int e0; };
  const bf16_t *P, *kbase, *vbase; bf16_t* Y; const float* rpb; float* tbl; int ldp, NT, b, h, u, krA, ntr;
  __device__ __forceinline__ void init(const Params& p, const float* rpb_layer, char* lds, int i) {
    P = (const bf16_t*)(p.ws + WS_P); Y = (bf16_t*)(p.ws + WS_Y); ldp = 8192; tbl = (float*)(lds + LDS_TBL);
    const int m = meta ? i : i >> 3; u = meta ? 0 : i & 7; h = m & 15; b = m >> 4; rpb = rpb_layer + h * 15 * 31;
    krA = min(max(4 * u - 4, 0), 24); const int krB = min(max(4 * u - 1, 0), 24) + 7; ntr = meta ? 0 : krB - krA + 1; NT = ntr + 1;
    kbase = P + 2048 + h * 128; vbase = P + 4096 + h * 128;
  }
  __device__ __forceinline__ int grow(int wid) const { return 4 * u + (wid >> 1); }
  __device__ __forceinline__ int qrow(int wid, int r) const { return meta ? MREAL + b * 16 + (r & 15) : b * 2048 + grow(wid) * 64 + 32 * (wid & 1) + r; }
  __device__ __forceinline__ const bf16_t* qptr(int wid, int r32) const { return P + (size_t)qrow(wid, r32) * 8192 + h * 128; }
  __device__ __forceinline__ int krow(int t, int i) const { return t < ntr ? b * 2048 + (krA + t) * 64 + i : MREAL + b * 16 + (i & 15); }
  __device__ __forceinline__ bool active(int wid, int t) const {
    if (meta) return wid == 0;
    if (t >= ntr) return true;
    const int r0 = min(max(grow(wid) - 4, 0), 24), kr = krA + t; return kr >= r0 && kr <= r0 + 7; }
  __device__ __forceinline__ void prep(char* lds, int tid) const {
    if (!meta) {
#pragma unroll
      for (int k = 0; k < 4; ++k) { const int e = tid + 512 * k; if (e < 15 * 128) { const int dr = e >> 7, dc = (e & 127) - 63;
          tbl[e] = (dc >= -15 && dc <= 15) ? rpb[dr * 31 + dc + 15] * 1.4426950408889634f : NEG; } } }
  }
  __device__ __forceinline__ Lane lane_init(int wid, int r32, int hi) const {
    Lane L; const int c = 32 * (wid & 1) + r32, c0 = min(max(c - 8, 0), 48);
    L.tb = tbl + (7 - grow(wid)) * 128 + (63 - c + 4 * hi);
    L.e0 = 4 * hi - c0; return L; }
  __device__ __forceinline__ void bias(const Lane& L, f32x16& p0, f32x16& p1, int t, int hi) const {
    if (!meta && t < ntr) { const float* tb = L.tb + (krA + t) * 128;
#pragma unroll
      for (int r = 0; r < 16; ++r) {
        p0[r] = ((unsigned)(crow_c(r) + L.e0) < 16u) ? p0[r] + tb[crow_c(r)] : NEG;
        p1[r] = ((unsigned)(crow_c(r) + 32 + L.e0) < 16u) ? p1[r] + tb[crow_c(r) + 32] : NEG; } }
    else {
#pragma unroll
      for (int r = 0; r < 16; ++r) { if (r >= 8) p0[r] = NEG; p1[r] = NEG; } }
  }
  __device__ __forceinline__ float final_l(float l, float m, int wid) const { return l; }
  __device__ __forceinline__ bool row_valid(int wid, int orow) const { return !meta || (wid == 0 && orow < 16); }
  __device__ __forceinline__ void emit(int wid, int orow, int col, float v) const {
    const int R = qrow(wid, orow); const float z = bf2f(P[(size_t)R * 8192 + 6144 + h * 128 + col]);
    Y[(size_t)R * DM + h * 128 + col] = (bf16_t)f2bf(v * silu(z)); }
  __device__ __forceinline__ void emit8(int wid, int orow, int col, f32x4 a, f32x4 c) const {
    const int R = qrow(wid, orow); const u32x4 z = *(const u32x4*)(P + (size_t)R * 8192 + 6144 + h * 128 + col); u32x4 w;
    w.x = pk2(a[0] * silu(__uint_as_float(z.x << 16)), a[1] * silu(__uint_as_float(z.x & 0xffff0000u))); w.y = pk2(a[2] * silu(__uint_as_float(z.y << 16)), a[3] * silu(__uint_as_float(z.y & 0xffff0000u)));
    w.z = pk2(c[0] * silu(__uint_as_float(z.z << 16)), c[1] * silu(__uint_as_float(z.z & 0xffff0000u))); w.w = pk2(c[2] * silu(__uint_as_float(z.w << 16)), c[3] * silu(__uint_as_float(z.w & 0xffff0000u)));
    *(u32x4*)(Y + (size_t)R * DM + h * 128 + col) = w; }
};
}

__device__ __forceinline__ void phase_attn_swa_mfma(const Params& p, char* lds) {
    int tid = threadIdx.x; asm volatile("" : "+v"(tid));
    const int G = gridDim.x, bx = blockIdx.x, vcu = (G % 8 == 0) ? (bx % 8) * (G / 8) + bx / 8 : bx;
    for (int i = vcu; i < 512; i += G) { att::SwaUnitT<false> U; U.init(p, i); att::attn_unit<att::SwaUnitT<false>, 1>(U, lds, tid); }
    for (int i = vcu; i < 16; i += G) { att::SwaUnitT<true> U; U.init(p, i); att::attn_unit_skip(U, lds, tid); }
}
__device__ __forceinline__ void phase_attn_na_mfma(const Params& p, const float* rpb_layer, char* lds, bool with_meta) {
    int tid = threadIdx.x; asm volatile("" : "+v"(tid));
    const int G = gridDim.x, bx = blockIdx.x, vcu = (G % 8 == 0) ? (bx % 8) * (G / 8) + bx / 8 : bx;
    for (int i = vcu; i < 512; i += G) { att::NaUnitT<false> U; U.init(p, rpb_layer, lds, i); att::attn_unit_skip(U, lds, tid); }
    if (with_meta) for (int i = vcu; i < 64; i += G) { att::NaUnitT<true> U; U.init(p, rpb_layer, lds, i); att::attn_unit_skip(U, lds, tid); }
}


__device__ __forceinline__ void phase_attn_diff_mfma(const Params& p, char* lds) {
    int tid = threadIdx.x; asm volatile("" : "+v"(tid));
    const int G = gridDim.x, bx = blockIdx.x, vcu = (G % 8 == 0) ? (bx % 8) * (G / 8) + bx / 8 : bx;
    for (int i = vcu; i < 1024; i += G) { att::DiffUnitT<false> U; U.init(p.ws, i); att::attn_unit<att::DiffUnitT<false>, 1, true>(U, lds, tid); }
    if (vcu & 1) { att::DiffUnitT<true> U; U.init(p.ws, 1024 + (vcu >> 1)); att::attn_unit_splitk(U, lds, tid); }
}
__device__ __forceinline__ void phase_diff_combine(const Params& p) {
    int tid = threadIdx.x; asm volatile("" : "+v"(tid)); const int lane = tid & 63, wave = tid >> 6;
    const bf16_t* P = (const bf16_t*)(p.ws + WS_P); const bf16_t* OD = (const bf16_t*)(p.ws + WS_OD); bf16_t* Y = (bf16_t*)(p.ws + WS_Y);
    const int gw = blockIdx.x * NWAVES + wave, NGW = gridDim.x * NWAVES;
    const float l1 = p.lq1[lane] * p.lk1[lane] + p.lq1[lane + 64] * p.lk1[lane + 64], l2 = p.lq2[lane] * p.lk2[lane] + p.lq2[lane + 64] * p.lk2[lane + 64];
    const float lam = __expf(wave_sum(l1)) - __expf(wave_sum(l2)) + LAMBDA_INIT_L1;
    const f32x4 g = *(const f32x4*)(p.subg + 4 * lane);
    constexpr int NT4 = 4;
    for (int task0 = gw; task0 < MTOT * 8; task0 += NT4 * NGW) {
        uint2 a[NT4], c[NT4], zz[NT4]; int Rr[NT4], hh[NT4]; bool ok[NT4];
#pragma unroll
        for (int i = 0; i < NT4; ++i) { int task = task0 + i * NGW; ok[i] = task < MTOT * 8; if (!ok[i]) task = task0; Rr[i] = task >> 3; hh[i] = task & 7;
            a[i] = *(const uint2*)(OD + (size_t)Rr[i] * 4096 + hh[i] * 512 + 4 * lane); c[i] = *(const uint2*)(OD + (size_t)Rr[i] * 4096 + hh[i] * 512 + 256 + 4 * lane);
            zz[i] = *(const uint2*)(P + (size_t)Rr[i] * 8192 + 6144 + hh[i] * 256 + 4 * lane); }
#pragma unroll
        for (int i = 0; i < NT4; ++i) {
            float o[4];
            o[0] = __uint_as_float(a[i].x << 16) - lam * __uint_as_float(c[i].x << 16); o[1] = __uint_as_float(a[i].x & 0xffff0000u) - lam * __uint_as_float(c[i].x & 0xffff0000u);
            o[2] = __uint_as_float(a[i].y << 16) - lam * __uint_as_float(c[i].y << 16); o[3] = __uint_as_float(a[i].y & 0xffff0000u) - lam * __uint_as_float(c[i].y & 0xffff0000u);
            const float ss = wave_sum(o[0] * o[0] + o[1] * o[1] + o[2] * o[2] + o[3] * o[3]);
            const float rinv = 1.f / sqrtf(ss * (1.f / 256.f) + RMS_EPS) * (1.f - LAMBDA_INIT_L1);
            const float y0 = o[0] * rinv * g[0] * silu(__uint_as_float(zz[i].x << 16)), y1 = o[1] * rinv * g[1] * silu(__uint_as_float(zz[i].x & 0xffff0000u));
            const float y2 = o[2] * rinv * g[2] * silu(__uint_as_float(zz[i].y << 16)), y3 = o[3] * rinv * g[3] * silu(__uint_as_float(zz[i].y & 0xffff0000u));
            uint2 ov; ov.x = pk2(y0, y1); ov.y = pk2(y2, y3);
            if (ok[i]) *(uint2*)(Y + (size_t)Rr[i] * DM + hh[i] * 256 + 4 * lane) = ov; }
    }
}

#define RLX_AGENT __ATOMIC_RELAXED, __HIP_MEMORY_SCOPE_AGENT
#define XB_TMO      128
#define XB_XCNT(j)  (256  + 64 * (j))
#define XB_XSUB(j)  (1280 + 64 * (j))
#define XB_XGEN(j)  (2304 + 64 * (j))
#define XB_TOP      3328
#define XB_TOPGEN   3392
#define XCD_BAR_WORDS 3456
#define XB_SPIN_CAP (1u << 18)

__device__ __forceinline__ unsigned xb_ld(unsigned* p)              { return __hip_atomic_load(p, __ATOMIC_RELAXED, __HIP_MEMORY_SCOPE_AGENT); }
__device__ __forceinline__ unsigned xb_add(unsigned* p, unsigned v) { return __hip_atomic_fetch_add(p, v, __ATOMIC_RELAXED, __HIP_MEMORY_SCOPE_AGENT); }
__device__ __forceinline__ unsigned xb_xcc_id() { return (unsigned)__builtin_amdgcn_s_getreg((3 << 11) | 20) & 0xFu; }
#define XB_SPIN(cond, bar) do { unsigned _sp = 0; while (cond) { __builtin_amdgcn_s_sleep(1); \
    if ((++_sp & 255u) == 0u) { if (xb_ld(&(bar)[XB_TMO])) break; if (_sp > XB_SPIN_CAP) { atomicAdd(&(bar)[XB_TMO], 1u); break; } } } } while (0)

struct XcdBarrier {
    unsigned* bar; unsigned x;
    volatile LAS unsigned* st;
};

__device__ __forceinline__ XcdBarrier xcd_barrier_post(unsigned* bar, volatile LAS unsigned* st) {
    XcdBarrier b; b.bar = bar; b.x = xb_xcc_id(); b.st = st;
    if (threadIdx.x == 0) (void)xb_add(&bar[XB_XCNT(b.x)], 1u);
    return b;
}
__device__ __forceinline__ void xcd_barrier_complete(unsigned* bar, unsigned x, unsigned& nloc, unsigned& nx) {
    const unsigned G = gridDim.x * gridDim.y * gridDim.z;
    unsigned sum, cnt, mine, sp = 0u;
    for (;;) {
        sum = 0u; cnt = 0u; mine = 0u;
#pragma unroll
        for (unsigned j = 0; j < 16; ++j) { const unsigned c = xb_ld(&bar[XB_XCNT(j)]); sum += c; cnt += (c > 0u) ? 1u : 0u; mine = (j == x) ? c : mine; }
        if (sum == G) break;
        __builtin_amdgcn_s_sleep(1);
        if ((++sp & 255u) == 0u) { if (xb_ld(&bar[XB_TMO])) break; if (sp > XB_SPIN_CAP) { atomicAdd(&bar[XB_TMO], 1u); break; } }
    }
    nloc = mine > 0u ? mine : 1u; nx = cnt > 0u ? cnt : 1u;
}

__device__ __forceinline__ void xcd_barrier(const XcdBarrier& b) {
    asm volatile("s_waitcnt vmcnt(0)" ::: "memory");
    __syncthreads();
    if (threadIdx.x == 0) {
        unsigned* bar = b.bar;
        __builtin_amdgcn_s_waitcnt(0);
        unsigned nloc = b.st[0], nx = b.st[1];
        if (nloc == 0u) { xcd_barrier_complete(bar, b.x, nloc, nx); b.st[0] = nloc; b.st[1] = nx; }
        const unsigned old = xb_add(&bar[XB_XSUB(b.x)], 1u);
        const unsigned gen = old / nloc;
        if (old + 1u == (gen + 1u) * nloc) {
            __builtin_amdgcn_fence(__ATOMIC_RELEASE, "agent");
            asm volatile("s_waitcnt vmcnt(0)" ::: "memory");
            const unsigned og = xb_add(&bar[XB_TOP], 1u);
            const unsigned tg = og / nx;
            if (og + 1u == (tg + 1u) * nx) xb_add(&bar[XB_TOPGEN], 1u);
            else XB_SPIN(xb_ld(&bar[XB_TOPGEN]) == tg, bar);
            __builtin_amdgcn_fence(__ATOMIC_ACQUIRE, "agent");
            xb_add(&bar[XB_XGEN(b.x)], 1u);
            asm volatile("s_waitcnt vmcnt(0)" ::: "memory");
        } else {
            XB_SPIN(xb_ld(&bar[XB_XGEN(b.x)]) == gen, bar);
            __builtin_amdgcn_fence(__ATOMIC_ACQUIRE, "agent");
            asm volatile("s_waitcnt vmcnt(0)" ::: "memory");
        }
    }
    __syncthreads();
}


#define GRID_SYNC() do { XcdBarrier b_; b_.bar = (unsigned*)(p.ws + WS_CTL); b_.x = xb_xcc_id(); b_.st = (volatile LAS unsigned*)((LAS unsigned char*)lds_raw + LDS_MISC); xcd_barrier(b_); } while (0)
__global__ void __launch_bounds__(NTHREADS, 2) mega(Params p) {
    extern __shared__ __attribute__((aligned(16))) unsigned char lds_raw[];
    float* lds = (float*)lds_raw; PG8_LAS unsigned char* lds3 = (PG8_LAS unsigned char*)lds_raw;
    volatile LAS unsigned* misc = (volatile LAS unsigned*)((LAS unsigned char*)lds_raw + LDS_MISC);
    if (threadIdx.x < 16) misc[threadIdx.x] = 0u;
    __syncthreads();
    (void)xcd_barrier_post((unsigned*)(p.ws + WS_CTL), misc);
    const bf16_t* HB = (const bf16_t*)(p.ws + WS_HB);
    phase_prep(p, lds);
    GRID_SYNC();
    for (int layer = 0; layer < 4; ++layer) {
        const int kind = layer % 3;
        const bf16_t* Wt = (const bf16_t*)(p.ws + (layer == 0 ? WS_WA0 : layer == 1 ? WS_WB : layer == 2 ? WS_WC : WS_WA1));
        { const int N = kind == 2 ? 5120 : 8192; pg8::Gemm g{HB, Wt, MREAL, N, DM}; pg8::StaticOrder S; S.init(MREAL, N, (int)gridDim.x, (int)blockIdx.x);
          pg8::EpiBf16s E{(bf16_t*)(p.ws + WS_P), N, 2048, QPRE};
          pg8::gemm_phase<pg8::EpiBf16s, pg8::StaticOrder, true, true>(lds3, g, S, E);
          phase_gemm_meta<0, 2>(HB, Wt, N, p.ws + WS_P, nullptr, lds, kind == 2 ? 128 : 0); }
        GRID_SYNC();
        if (kind == 0) phase_attn_na_mfma(p, p.rpb_a + (size_t)(layer / 3) * 16 * 15 * 31, (char*)lds_raw, layer < 3);
        else if (kind == 1) { phase_attn_diff_mfma(p, (char*)lds_raw); GRID_SYNC(); phase_diff_combine(p); }
        else phase_attn_swa_mfma(p, (char*)lds_raw);
        GRID_SYNC();
        { pg8::Gemm g{(const bf16_t*)(p.ws + WS_Y), (const bf16_t*)(p.ws + WS_WO) + (size_t)layer * DM * DM, MREAL, DM, DM}; pg8::StaticOrder S; S.init(MREAL, DM, (int)gridDim.x, (int)blockIdx.x);
          const float* lg = layer ? p.ln_g + (layer - 1) * DM : nullptr; const float* lb = layer ? p.ln_b + (layer - 1) * DM : nullptr;
          pg8::EpiResF32 E{(float*)(p.ws + WS_H32), layer == 0 ? p.x : nullptr, (const float*)(p.ws + WS_ST), lg, lb, DM, ALPHA};
          pg8::gemm_phase<pg8::EpiResF32, pg8::StaticOrder, true, true>(lds3, g, S, E);
          if (layer < 3) phase_gemm_meta<1, 1>((const bf16_t*)(p.ws + WS_Y), (const bf16_t*)(p.ws + WS_WO) + (size_t)layer * DM * DM, DM, p.ws + WS_H32, layer ? (const float*)(p.ws + WS_ST) : nullptr, lds, 0, lg, lb); }
        GRID_SYNC();
        phase_ln(p, layer, layer == 3, layer == 3 ? MREAL : MTOT);
        if (layer < 3) GRID_SYNC();
    }
}

extern "C" void kernel_launch(void* const* d_in, const int* in_sizes, int n_in, void* d_out, int out_size, void* d_ws, size_t ws_size, hipStream_t stream) {
    if (n_in != 15 || ws_size < WS_END) { fprintf(stderr, "kernel_launch: unexpected n_in %d or ws_size %zu (< %zu)\n", n_in, ws_size, (size_t)WS_END); return; }
    Params p{};
    p.x = (const float*)d_in[0]; p.meta = (const float*)d_in[1]; p.w_in_a = (const float*)d_in[2]; p.rpb_a = (const float*)d_in[3]; p.w_in_b = (const float*)d_in[4];
    p.lq1 = (const float*)d_in[5]; p.lk1 = (const float*)d_in[6]; p.lq2 = (const float*)d_in[7]; p.lk2 = (const float*)d_in[8]; p.subg = (const float*)d_in[9];
    p.w_in_c = (const float*)d_in[10]; p.sink = (const float*)d_in[11]; p.w_out = (const float*)d_in[12]; p.ln_g = (const float*)d_in[13]; p.ln_b = (const float*)d_in[14];
    p.out = (float*)d_out; p.ws = (unsigned char*)d_ws;
    constexpr int LDSB = LDS_TOTAL;
    static int grid = 0;
    if (grid == 0) {
        int dev = 0, cus = 0, per_cu = 0;
        (void)hipGetDevice(&dev);
        (void)hipDeviceGetAttribute(&cus, hipDeviceAttributeMultiprocessorCount, dev);
        (void)hipFuncSetAttribute((const void*)mega, hipFuncAttributeMaxDynamicSharedMemorySize, LDSB);
        (void)hipOccupancyMaxActiveBlocksPerMultiprocessor(&per_cu, (const void*)mega, NTHREADS, LDSB);
        if (per_cu < 1) fprintf(stderr, "kernel_launch: occupancy query says %d blocks/CU\n", per_cu);
        (void)hipGetLastError();
        grid = cus;
    }
    (void)hipMemsetAsync((char*)d_ws + WS_CTL, 0, CTL_BYTES, stream);
    hipLaunchKernelGGL(mega, dim3(grid), dim3(NTHREADS), LDSB, stream, p);
    const hipError_t le = hipPeekAtLastError();
    if (le != hipSuccess) fprintf(stderr, "kernel_launch: launch failed: %s (grid %d)\n", hipGetErrorName(le), grid);
}
```

```cpp
#include <hip/hip_runtime.h>
#include <cstdio>
#include <cstdint>

#define LAS __attribute__((address_space(3)))
typedef unsigned short bf16_t;
typedef unsigned v4u __attribute__((ext_vector_type(4)));
typedef float f32x4 __attribute__((ext_vector_type(4)));

constexpr int DM = 2048, NBATCH = 4, SEQ = 2048, NMETA = 16;
constexpr int MREAL = NBATCH * SEQ;
constexpr int MTOT = MREAL + NBATCH * NMETA;
constexpr int MPAD = 8448;
constexpr int NWAVES = 8, NTHREADS = 512;
constexpr int LDS_TOTAL = 144 * 1024, LDS_MISC = LDS_TOTAL - 256;
constexpr float LN_EPS = 1e-5f, RMS_EPS = 1e-5f;
constexpr float ALPHA = 1.681792830507429f;
constexpr float QSCALE = 0.6931471805599453f;
constexpr float QPRE = 0.08838834764831845f * 1.4426950408889634f;
constexpr float LAMBDA_INIT_L1 = 0.35550906759096f;

constexpr size_t MiB = 1u << 20;
constexpr size_t WS_WA0 = 0, WS_WA1 = 32 * MiB, WS_WB = 64 * MiB, WS_WC = 96 * MiB, WS_WO = 116 * MiB;
constexpr size_t WS_H32 = 148 * MiB;
constexpr size_t WS_HB = 214 * MiB;
constexpr size_t WS_Y = 247 * MiB;
constexpr size_t WS_P = 280 * MiB;
constexpr size_t WS_PRE = WS_P;
constexpr size_t WS_OD = 412 * MiB;
constexpr size_t WS_CTL = 478 * MiB, CTL_BYTES = 64 * 1024;
constexpr size_t WS_ST = 479 * MiB;
constexpr size_t WS_END = 480 * MiB;

struct Params {
    const float* x; const float* meta; const float* w_in_a; const float* rpb_a; const float* w_in_b;
    const float* lq1; const float* lk1; const float* lq2; const float* lk2; const float* subg;
    const float* w_in_c; const float* sink; const float* w_out; const float* ln_g; const float* ln_b;
    float* out; unsigned char* ws;
};

__device__ __forceinline__ float bf2f(bf16_t v) { return __uint_as_float(((unsigned)v) << 16); }
__device__ __forceinline__ unsigned f2bf(float f) { unsigned u = __float_as_uint(f); return (u + 0x7fffu + ((u >> 16) & 1u)) >> 16; }
__device__ __forceinline__ unsigned pk2(float lo, float hi) { return f2bf(lo) | (f2bf(hi) << 16); }
__device__ __forceinline__ float wave_sum(float v) {
#pragma unroll
    for (int o = 1; o < 64; o <<= 1) v += __shfl_xor(v, o);
    return v;
}
__device__ __forceinline__ float wave_max(float v) {
#pragma unroll
    for (int o = 1; o < 64; o <<= 1) v = fmaxf(v, __shfl_xor(v, o));
    return v;
}
__device__ __forceinline__ float silu(float z) { return z / (1.f + __expf(-z)); }

__device__ __forceinline__ void transpose_item(const float* W, int K, int N, bf16_t* WT, float* scr, int item, int lane) {
    const int nblk = N / 32, kb = item / nblk, nb = item % nblk, k0 = 64 * kb, n0 = 32 * nb;
#pragma unroll 8
    for (int i = 0; i < 32; ++i) { const int kk = 2 * i + (lane >> 5); scr[kk * 33 + (lane & 31)] = W[(size_t)(k0 + kk) * N + n0 + (lane & 31)]; }
    __builtin_amdgcn_s_waitcnt(0); asm volatile("" ::: "memory");
    const int c = lane & 7;
#pragma unroll
    for (int j = 0; j < 4; ++j) { const int n = (lane >> 3) + 8 * j; const float* s = scr + (8 * c) * 33 + n;
        v4u o; o.x = pk2(s[0 * 33], s[1 * 33]); o.y = pk2(s[2 * 33], s[3 * 33]); o.z = pk2(s[4 * 33], s[5 * 33]); o.w = pk2(s[6 * 33], s[7 * 33]);
        *(v4u*)(WT + (size_t)(n0 + n) * K + k0 + 8 * c) = o; }
    __builtin_amdgcn_s_waitcnt(0); asm volatile("" ::: "memory");
}
__device__ __forceinline__ void phase_prep(const Params& p, float* lds) {
    int tid = threadIdx.x; asm volatile("" : "+v"(tid)); const int lane = tid & 63, wave = tid >> 6;
    float* scr = lds + wave * (64 * 33);
    const int gw = blockIdx.x * NWAVES + wave, NGW = gridDim.x * NWAVES;
    constexpr int I_A = 8192, I_C = 5120, I_O = 2048;
    constexpr int NITEMS = 3 * I_A + I_C + 4 * I_O;
    for (int it = gw; it < NITEMS; it += NGW) {
        int r = it;
        if (r < I_A) { transpose_item(p.w_in_a, DM, 8192, (bf16_t*)(p.ws + WS_WA0), scr, r, lane); continue; } r -= I_A;
        if (r < I_A) { transpose_item(p.w_in_a + (size_t)DM * 8192, DM, 8192, (bf16_t*)(p.ws + WS_WA1), scr, r, lane); continue; } r -= I_A;
        if (r < I_A) { transpose_item(p.w_in_b, DM, 8192, (bf16_t*)(p.ws + WS_WB), scr, r, lane); continue; } r -= I_A;
        if (r < I_C) { transpose_item(p.w_in_c, DM, 5120, (bf16_t*)(p.ws + WS_WC), scr, r, lane); continue; } r -= I_C;
        const int li = r / I_O; r -= li * I_O;
        transpose_item(p.w_out + (size_t)li * DM * DM, DM, DM, (bf16_t*)(p.ws + WS_WO) + (size_t)li * DM * DM, scr, r, lane);
    }
    float* H32 = (float*)(p.ws + WS_H32); bf16_t* HB = (bf16_t*)(p.ws + WS_HB);
    for (int R = gw; R < MTOT; R += NGW) {
        const float* src = nullptr;
        if (R < MREAL) src = p.x + (size_t)R * DM; else if (R < MTOT) src = p.meta + (size_t)((R - MREAL) & 15) * DM;
#pragma unroll
        for (int j = 0; j < 8; ++j) {
            const int c = j * 256 + lane * 4;
            f32x4 v = src ? *(const f32x4*)(src + c) : (f32x4){0.f, 0.f, 0.f, 0.f};
            if (R >= MREAL) *(f32x4*)(H32 + (size_t)R * DM + c) = v;
            uint2 o; o.x = pk2(v[0], v[1]); o.y = pk2(v[2], v[3]);
            *(uint2*)(HB + (size_t)R * DM + c) = o;
        }
    }
}

template <int MODE>
__device__ __forceinline__ void phase_gemm_naive(const bf16_t* A, const bf16_t* Bt, int M, int N, int K, void* Cout, const float* H32, float* lds) {
    const int tid = threadIdx.x, ty = tid >> 4, tx = tid & 15;
    float* As = lds;
    float* Bs = lds + 32 * 132;
    const int ntm = M / 128, ntn = N / 64, ntiles = ntm * ntn;
    for (int t = blockIdx.x; t < ntiles; t += gridDim.x) {
        const int tm = t / ntn, tn = t % ntn, m0 = tm * 128, n0 = tn * 64;
        float acc[4][4];
#pragma unroll
        for (int i = 0; i < 4; ++i)
#pragma unroll
            for (int j = 0; j < 4; ++j) acc[i][j] = 0.f;
        for (int k0 = 0; k0 < K; k0 += 32) {
            __syncthreads();
            { const int r = tid >> 2, kc = (tid & 3) * 8; const v4u v = *(const v4u*)(A + (size_t)(m0 + r) * K + k0 + kc);
#pragma unroll
              for (int j = 0; j < 4; ++j) { As[(kc + 2 * j) * 132 + r] = __uint_as_float(v[j] << 16); As[(kc + 2 * j + 1) * 132 + r] = __uint_as_float(v[j] & 0xffff0000u); } }
            if (tid < 256) { const int r = tid >> 2, kc = (tid & 3) * 8; const v4u v = *(const v4u*)(Bt + (size_t)(n0 + r) * K + k0 + kc);
#pragma unroll
              for (int j = 0; j < 4; ++j) { Bs[(kc + 2 * j) * 68 + r] = __uint_as_float(v[j] << 16); Bs[(kc + 2 * j + 1) * 68 + r] = __uint_as_float(v[j] & 0xffff0000u); } }
            __syncthreads();
#pragma unroll 8
            for (int k = 0; k < 32; ++k) {
                const f32x4 a = *(const f32x4*)(As + k * 132 + ty * 4), b = *(const f32x4*)(Bs + k * 68 + tx * 4);
#pragma unroll
                for (int i = 0; i < 4; ++i)
#pragma unroll
                    for (int j = 0; j < 4; ++j) acc[i][j] += a[i] * b[j];
            }
        }
#pragma unroll
        for (int i = 0; i < 4; ++i) {
            const int row = m0 + ty * 4 + i, col = n0 + tx * 4;
            if (MODE == 0) { uint2 o; o.x = pk2(acc[i][0], acc[i][1]); o.y = pk2(acc[i][2], acc[i][3]); *(uint2*)((bf16_t*)Cout + (size_t)row * N + col) = o; }
            else { const f32x4 h = *(const f32x4*)(H32 + (size_t)row * DM + col); f32x4 o;
#pragma unroll
                for (int j = 0; j < 4; ++j) o[j] = ALPHA * h[j] + acc[i][j];
                *(f32x4*)((float*)Cout + (size_t)row * DM + col) = o; }
        }
    }
}

__device__ __forceinline__ float dot128(const float* q, const bf16_t* k) {
    float s = 0.f;
#pragma unroll 4
    for (int c = 0; c < 16; ++c) { const v4u v = *(const v4u*)(k + c * 8);
#pragma unroll
        for (int j = 0; j < 4; ++j) { s += q[c * 8 + 2 * j] * __uint_as_float(v[j] << 16); s += q[c * 8 + 2 * j + 1] * __uint_as_float(v[j] & 0xffff0000u); } }
    return s;
}

__device__ __forceinline__ void phase_attn_na(const Params& p, const float* rpb, float* lds) {
    int tid = threadIdx.x; asm volatile("" : "+v"(tid)); const int lane = tid & 63, wave = tid >> 6;
    float* qs = lds + wave * 512; float* ps = qs + 128;
    const bf16_t* P = (const bf16_t*)(p.ws + WS_P); bf16_t* Y = (bf16_t*)(p.ws + WS_Y);
    const int gw = blockIdx.x * NWAVES + wave, NGW = gridDim.x * NWAVES;
    for (int task = gw; task < MTOT * 16; task += NGW) {
        const int R = task >> 4, h = task & 15;
        const bf16_t* qrow = P + (size_t)R * 8192 + h * 128;
        qs[lane] = bf2f(qrow[lane]); qs[lane + 64] = bf2f(qrow[lane + 64]);
        __builtin_amdgcn_s_waitcnt(0); asm volatile("" ::: "memory");
        int nkeys, b, r = 0, c = 0, r0 = 0, c0 = 0; const bool meta = R >= MREAL;
        if (meta) { b = (R - MREAL) >> 4; nkeys = 16; }
        else { b = R >> 11; const int s = R & 2047; r = s >> 6; c = s & 63; r0 = min(max(r - 4, 0), 24); c0 = min(max(c - 8, 0), 48); nkeys = 144; }
        float sc[3]; float mx = -3.0e38f;
#pragma unroll
        for (int it = 0; it < 3; ++it) {
            const int idx = it * 64 + lane; sc[it] = -3.0e38f;
            if (idx < nkeys) {
                int krow; float bias = 0.f;
                if (idx < 16) krow = MREAL + b * 16 + idx;
                else { const int i = (idx - 16) >> 4, j = (idx - 16) & 15; krow = b * 2048 + (r0 + i) * 64 + (c0 + j);
                       bias = rpb[(h * 15 + (r0 + i - r + 7)) * 31 + (c0 + j - c + 15)]; }
                sc[it] = dot128(qs, P + (size_t)krow * 8192 + 2048 + h * 128) * QSCALE + bias;
            }
            mx = fmaxf(mx, sc[it]);
        }
        mx = wave_max(mx);
        float sum = 0.f;
#pragma unroll
        for (int it = 0; it < 3; ++it) { const int idx = it * 64 + lane; float e = 0.f; if (idx < nkeys) e = __expf(sc[it] - mx); sum += e; if (idx < 192) ps[idx] = e; }
        sum = wave_sum(sum);
        __builtin_amdgcn_s_waitcnt(0); asm volatile("" ::: "memory");
        const float inv = 1.f / sum;
        float o0 = 0.f, o1 = 0.f;
        for (int idx = 0; idx < nkeys; ++idx) {
            int krow;
            if (idx < 16) krow = MREAL + b * 16 + idx;
            else { const int i = (idx - 16) >> 4, j = (idx - 16) & 15; krow = b * 2048 + (r0 + i) * 64 + (c0 + j); }
            const unsigned v = *(const unsigned*)(P + (size_t)krow * 8192 + 4096 + h * 128 + 2 * lane);
            const float pw = ps[idx];
            o0 += pw * __uint_as_float(v << 16); o1 += pw * __uint_as_float(v & 0xffff0000u);
        }
        const unsigned zz = *(const unsigned*)(P + (size_t)R * 8192 + 6144 + h * 128 + 2 * lane);
        const float y0 = o0 * inv * silu(__uint_as_float(zz << 16)), y1 = o1 * inv * silu(__uint_as_float(zz & 0xffff0000u));
        *(unsigned*)(Y + (size_t)R * DM + h * 128 + 2 * lane) = pk2(y0, y1);
        __builtin_amdgcn_s_waitcnt(0); asm volatile("" ::: "memory");
    }
}

__device__ __forceinline__ void phase_attn_diff(const Params& p, float* lds) {
    int tid = threadIdx.x; asm volatile("" : "+v"(tid)); const int lane = tid & 63, wave = tid >> 6;
    float* qs = lds + wave * 4352; float* as = qs + 128; float* tmp = as + 2112;
    const bf16_t* P = (const bf16_t*)(p.ws + WS_P); bf16_t* Y = (bf16_t*)(p.ws + WS_Y);
    const int gw = blockIdx.x * NWAVES + wave, NGW = gridDim.x * NWAVES;
    float l1 = 0.f, l2 = 0.f;
    { l1 = p.lq1[lane] * p.lk1[lane] + p.lq1[lane + 64] * p.lk1[lane + 64]; l2 = p.lq2[lane] * p.lk2[lane] + p.lq2[lane + 64] * p.lk2[lane + 64]; }
    const float lam = __expf(wave_sum(l1)) - __expf(wave_sum(l2)) + LAMBDA_INIT_L1;
    constexpr int LK = 2064, NIT = (LK + 63) / 64;
    for (int task = gw; task < MTOT * 8; task += NGW) {
        const int R = task >> 3, h = task & 7;
        const bool meta = R >= MREAL; const int b = meta ? (R - MREAL) >> 4 : R >> 11; const int s = R & 2047;
        const float slope = exp2f(-(float)(h + 1));
        for (int j = 0; j < 2; ++j) {
            const bf16_t* qrow = P + (size_t)R * 8192 + h * 256 + j * 128;
            __builtin_amdgcn_s_waitcnt(0); asm volatile("" ::: "memory");
            qs[lane] = bf2f(qrow[lane]); qs[lane + 64] = bf2f(qrow[lane + 64]);
            __builtin_amdgcn_s_waitcnt(0); asm volatile("" ::: "memory");
            float mx = -3.0e38f;
            for (int it = 0; it < NIT; ++it) {
                const int idx = it * 64 + lane; float sv = -3.0e38f;
                if (idx < LK) {
                    int krow; float bias = 0.f;
                    if (idx < 16) krow = MREAL + b * 16 + idx;
                    else { const int t = idx - 16; krow = b * 2048 + t; if (!meta) bias = -slope * fabsf((float)(s - t)); }
                    sv = dot128(qs, P + (size_t)krow * 8192 + 2048 + h * 256 + j * 128) * QSCALE + bias;
                }
                tmp[idx] = sv; mx = fmaxf(mx, sv);
            }
            mx = wave_max(mx);
            float sum = 0.f;
            for (int it = 0; it < NIT; ++it) { const int idx = it * 64 + lane; float e = 0.f; if (idx < LK) e = __expf(tmp[idx] - mx); tmp[idx] = e; sum += e; }
            sum = wave_sum(sum);
            const float inv = 1.f / sum;
            for (int it = 0; it < NIT; ++it) { const int idx = it * 64 + lane; if (j == 0) as[idx] = tmp[idx] * inv; else as[idx] -= lam * tmp[idx] * inv; }
        }
        __builtin_amdgcn_s_waitcnt(0); asm volatile("" ::: "memory");
        float o[4] = {0.f, 0.f, 0.f, 0.f};
        for (int idx = 0; idx < LK; ++idx) {
            const int krow = idx < 16 ? MREAL + b * 16 + idx : b * 2048 + idx - 16;
            const uint2 v = *(const uint2*)(P + (size_t)krow * 8192 + 4096 + h * 256 + 4 * lane);
            const float a = as[idx];
            o[0] += a * __uint_as_float(v.x << 16); o[1] += a * __uint_as_float(v.x & 0xffff0000u);
            o[2] += a * __uint_as_float(v.y << 16); o[3] += a * __uint_as_float(v.y & 0xffff0000u);
        }
        const float ss = wave_sum(o[0] * o[0] + o[1] * o[1] + o[2] * o[2] + o[3] * o[3]);
        const float rinv = 1.f / sqrtf(ss * (1.f / 256.f) + RMS_EPS) * (1.f - LAMBDA_INIT_L1);
        const f32x4 g = *(const f32x4*)(p.subg + 4 * lane);
        const uint2 zz = *(const uint2*)(P + (size_t)R * 8192 + 6144 + h * 256 + 4 * lane);
        const float y0 = o[0] * rinv * g[0] * silu(__uint_as_float(zz.x << 16)), y1 = o[1] * rinv * g[1] * silu(__uint_as_float(zz.x & 0xffff0000u));
        const float y2 = o[2] * rinv * g[2] * silu(__uint_as_float(zz.y << 16)), y3 = o[3] * rinv * g[3] * silu(__uint_as_float(zz.y & 0xffff0000u));
        uint2 ov; ov.x = pk2(y0, y1); ov.y = pk2(y2, y3);
        *(uint2*)(Y + (size_t)R * DM + h * 256 + 4 * lane) = ov;
    }
}

__device__ __forceinline__ void phase_attn_swa(const Params& p, float* lds) {
    int tid = threadIdx.x; asm volatile("" : "+v"(tid)); const int lane = tid & 63, wave = tid >> 6;
    float* qs = lds + wave * 512; float* ps = qs + 128;
    const bf16_t* P = (const bf16_t*)(p.ws + WS_P); bf16_t* Y = (bf16_t*)(p.ws + WS_Y);
    const int gw = blockIdx.x * NWAVES + wave, NGW = gridDim.x * NWAVES;
    constexpr int LDP = 5120;
    for (int task = gw; task < MTOT * 16; task += NGW) {
        const int R = task >> 4, hd = task & 15, kh = hd >> 2;
        const bf16_t* qrow = P + (size_t)R * LDP + hd * 128;
        qs[lane] = bf2f(qrow[lane]); qs[lane + 64] = bf2f(qrow[lane + 64]);
        __builtin_amdgcn_s_waitcnt(0); asm volatile("" ::: "memory");
        const bool meta = R >= MREAL; const int b = meta ? (R - MREAL) >> 4 : R >> 11; const int s = R & 2047;
        const int tlo = meta ? 0 : max(s - 128, 0), thi = meta ? -1 : min(s + 128, 2047);
        const int nkeys = 16 + (thi - tlo + 1);
        const float slope = exp2f(-0.5f * (float)(hd + 1)), sinkv = p.sink[hd];
        float sc[5]; float mx = sinkv;
#pragma unroll
        for (int it = 0; it < 5; ++it) {
            const int idx = it * 64 + lane; sc[it] = -3.0e38f;
            if (idx < nkeys) {
                int krow; float bias = 0.f;
                if (idx < 16) krow = MREAL + b * 16 + idx;
                else { const int t = tlo + idx - 16; krow = b * 2048 + t; bias = -slope * fabsf((float)(s - t)); }
                sc[it] = dot128(qs, P + (size_t)krow * LDP + 2048 + kh * 128) * QSCALE + bias;
            }
            mx = fmaxf(mx, sc[it]);
        }
        mx = wave_max(mx);
        float sum = 0.f;
#pragma unroll
        for (int it = 0; it < 5; ++it) { const int idx = it * 64 + lane; float e = 0.f; if (idx < nkeys) e = __expf(sc[it] - mx); sum += e; ps[idx] = e; }
        sum = wave_sum(sum) + __expf(sinkv - mx);
        __builtin_amdgcn_s_waitcnt(0); asm volatile("" ::: "memory");
        const float inv = 1.f / sum;
        float o0 = 0.f, o1 = 0.f;
        for (int idx = 0; idx < nkeys; ++idx) {
            const int krow = idx < 16 ? MREAL + b * 16 + idx : b * 2048 + tlo + idx - 16;
            const unsigned v = *(const unsigned*)(P + (size_t)krow * LDP + 2560 + kh * 128 + 2 * lane);
            const float pw = ps[idx];
            o0 += pw * __uint_as_float(v << 16); o1 += pw * __uint_as_float(v & 0xffff0000u);
        }
        const unsigned zz = *(const unsigned*)(P + (size_t)R * LDP + 3072 + hd * 128 + 2 * lane);
        const float y0 = o0 * inv * silu(__uint_as_float(zz << 16)), y1 = o1 * inv * silu(__uint_as_float(zz & 0xffff0000u));
        *(unsigned*)(Y + (size_t)R * DM + hd * 128 + 2 * lane) = pk2(y0, y1);
        __builtin_amdgcn_s_waitcnt(0); asm volatile("" ::: "memory");
    }
}

__device__ __forceinline__ void phase_ln(const Params& p, int layer, bool last, int nrows) {
    int tid = threadIdx.x; asm volatile("" : "+v"(tid)); const int lane = tid & 63, wave = tid >> 6;
    const int gw = blockIdx.x * NWAVES + wave, NGW = gridDim.x * NWAVES;
    const float* RES = (const float*)(p.ws + WS_H32); float* ST = (float*)(p.ws + WS_ST); bf16_t* HB = (bf16_t*)(p.ws + WS_HB);
    const float* g = p.ln_g + layer * DM; const float* bb = p.ln_b + layer * DM;
    constexpr int NR = 4;
    for (int R0 = gw; R0 < nrows; R0 += NR * NGW) {
        int Rr[NR]; bool ok[NR];
#pragma unroll
        for (int i = 0; i < NR; ++i) { Rr[i] = R0 + i * NGW; ok[i] = Rr[i] < nrows; if (!ok[i]) Rr[i] = R0; }
        f32x4 v[NR][8]; float mean[NR], rstd[NR];
#pragma unroll
        for (int i = 0; i < NR; ++i)
#pragma unroll
            for (int j = 0; j < 8; ++j) v[i][j] = *(const f32x4*)(RES + (size_t)Rr[i] * DM + j * 256 + lane * 4);
#pragma unroll
        for (int i = 0; i < NR; ++i) { float s = 0.f;
#pragma unroll
            for (int j = 0; j < 8; ++j) s += (v[i][j][0] + v[i][j][1]) + (v[i][j][2] + v[i][j][3]);
            mean[i] = wave_sum(s) * (1.f / DM); float q = 0.f;
#pragma unroll
            for (int j = 0; j < 8; ++j) { v[i][j] = v[i][j] - mean[i]; q += (v[i][j][0] * v[i][j][0] + v[i][j][1] * v[i][j][1]) + (v[i][j][2] * v[i][j][2] + v[i][j][3] * v[i][j][3]); }
            rstd[i] = 1.f / sqrtf(wave_sum(q) * (1.f / DM) + LN_EPS);
            if (!last && lane == 0 && ok[i]) { ST[2 * Rr[i]] = mean[i]; ST[2 * Rr[i] + 1] = rstd[i]; } }
#pragma unroll
        for (int j = 0; j < 8; ++j) {
            const int c = j * 256 + lane * 4;
            const f32x4 gg = *(const f32x4*)(g + c), bv = *(const f32x4*)(bb + c);
#pragma unroll
            for (int i = 0; i < NR; ++i) { const f32x4 o = v[i][j] * rstd[i] * gg + bv;
                if (ok[i]) { if (last) *(f32x4*)(p.out + (size_t)Rr[i] * DM + c) = o;
                             else { uint2 w; w.x = pk2(o[0], o[1]); w.y = pk2(o[2], o[3]); *(uint2*)(HB + (size_t)Rr[i] * DM + c) = w; } } }
        }
    }
}

namespace pg8 {
#define PG8_LAS __attribute__((address_space(3)))
typedef unsigned short bf16_t;
typedef short bf16x8 __attribute__((ext_vector_type(8)));
typedef float f32x4 __attribute__((ext_vector_type(4)));
typedef unsigned u32x4 __attribute__((ext_vector_type(4)));
constexpr int BM = 256, BK = 64, HALF = 128, HTB = HALF * BK * 2  , STAGE_BYTES = 8 * HTB, NXCD = 8, WGM = 8;

__host__ __device__ __forceinline__ int lds_byte(int r, int c) { const int st = (r >> 4) * 2 + (c >> 5), rr = r & 15, cc = c & 31, ob = rr * 64 + cc * 2; return st * 1024 + (ob ^ (((ob >> 9) & 1) << 5)); }
__host__ __device__ __forceinline__ void stage_rc(int b, int& R, int& C) { const int st = b / 1024, sb = b % 1024, swz = sb ^ (((sb >> 9) & 1) << 5); R = (st >> 1) * 16 + swz / 64; C = (st & 1) * 32 + (swz % 64) / 2; }
__host__ __device__ __forceinline__ int perm32(int rho) { const int n = rho >> 4, i = rho & 15; return 8 * (i >> 2) + 4 * n + (i & 3); }

struct Unit { int pm, pn; };
struct Gemm { const bf16_t* A; const bf16_t* Bt; int M, N, K; };

struct StaticOrder {
    int nM, nN, nwg, G, c;
    __host__ __device__ void init(int M, int N, int G_, int c_) { nM = M / BM; nN = N / BM; nwg = nM * nN; G = G_; c = c_; }
    __host__ __device__ bool next(int i, Unit& u) const {
        const long L = (long)i * G + c; if (L >= nwg) return false;
        int wgid = (int)L; { const int q = nwg / NXCD, r = nwg % NXCD, xcd = wgid % NXCD, off = wgid / NXCD; wgid = (xcd < r ? xcd * (q + 1) : r * (q + 1) + (xcd - r) * q) + off; }
        const int nig = WGM * nN, gid = wgid / nig, fm = gid * WGM, gsz = (nM - fm) < WGM ? (nM - fm) : WGM;
        u.pm = fm + ((wgid % nig) % gsz); u.pn = (wgid % nig) / gsz; return true;
    }
    __device__ __forceinline__ void a_ready(const Unit&) const {}
    __device__ __forceinline__ void done(const Unit&) const {}
};

typedef float f32x2c __attribute__((ext_vector_type(2))); typedef __bf16 bf16x2c __attribute__((ext_vector_type(2)));
__device__ __forceinline__ unsigned cvt_pk_bf16(float lo, float hi) { f32x2c v = {lo, hi}; bf16x2c b = __builtin_convertvector(v, bf16x2c); return __builtin_bit_cast(unsigned, b); }
typedef float f32x2 __attribute__((ext_vector_type(2)));

struct EpiBf16s {
    static constexpr bool PERM = true, AFTER_DRAIN = false;
    bf16_t* O; int ldc; int qcols; float qscale;
    __device__ __forceinline__ void operator()(const f32x4 (&acc)[2][2][4][2], const Unit& u, int wr, int wc, int fr, int fq) const {
        const int row0 = u.pm * BM + wr * 64 + fr, col0 = u.pn * BM + wc * 32 + 8 * fq; const float sc = (u.pn * BM < qcols) ? qscale : 1.f;
#pragma unroll
        for (int ai = 0; ai < 2; ++ai)
#pragma unroll
            for (int m = 0; m < 4; ++m) { bf16_t* rowp = O + (size_t)(row0 + ai * HALF + m * 16) * ldc + col0;
#pragma unroll
                for (int bj = 0; bj < 2; ++bj) { const f32x4 v0 = acc[ai][bj][m][0] * sc, v1 = acc[ai][bj][m][1] * sc;
                    u32x4 w; w.x = cvt_pk_bf16(v0[0], v0[1]); w.y = cvt_pk_bf16(v0[2], v0[3]); w.z = cvt_pk_bf16(v1[0], v1[1]); w.w = cvt_pk_bf16(v1[2], v1[3]);
                    *(u32x4*)(rowp + bj * HALF) = w; } }
    }
};
struct EpiResF32 {
    static constexpr bool PERM = false, AFTER_DRAIN = false;
    float* RES; const float* xin; const float* st; const float* g; const float* bvec; int ldc; float alpha;
    __device__ __forceinline__ void operator()(const f32x4 (&acc)[2][2][4][2], const Unit& u, int wr, int wc, int fr, int fq) const {
        typedef float f32x2v __attribute__((ext_vector_type(2)));
        const int row0 = u.pm * BM + wr * 64 + fr, col0 = u.pn * BM + wc * 32 + 4 * fq;
        f32x4 gq[2][2], bq[2][2];
#pragma unroll
        for (int bj = 0; bj < 2; ++bj)
#pragma unroll
            for (int n = 0; n < 2; ++n) { if (!xin) { gq[bj][n] = *(const f32x4*)(g + col0 + bj * HALF + n * 16); bq[bj][n] = *(const f32x4*)(bvec + col0 + bj * HALF + n * 16); }
                                          else { gq[bj][n] = (f32x4){1.f, 1.f, 1.f, 1.f}; bq[bj][n] = (f32x4){0.f, 0.f, 0.f, 0.f}; } }
#pragma unroll
        for (int ai = 0; ai < 2; ++ai)
#pragma unroll
            for (int m = 0; m < 4; ++m) { const int row = row0 + ai * HALF + m * 16; const size_t off = (size_t)row * ldc + col0;
                f32x2v sr = {0.f, 1.f}; if (!xin) sr = *(const f32x2v*)(st + 2 * row);
#pragma unroll
                for (int bj = 0; bj < 2; ++bj)
#pragma unroll
                    for (int n = 0; n < 2; ++n) { const size_t o2 = off + bj * HALF + n * 16;
                        f32x4 h;
                        if (xin) h = *(const f32x4*)(xin + o2); else h = (*(const f32x4*)(RES + o2) - sr.x) * sr.y * gq[bj][n] + bq[bj][n];
                        *(f32x4*)(RES + o2) = h * alpha + acc[ai][bj][m][n]; }
                if (m & 1) asm volatile("" ::: "memory"); }
    }
};

template <class Epi, class Sched, bool ALIGN_EPI = false, bool SP2 = false>
__device__ __forceinline__ void gemm_phase(PG8_LAS unsigned char* lds, const Gemm g, const Sched& S, const Epi& E) {
    int tid_ = threadIdx.x; asm volatile("" : "+v"(tid_));
    const int tid = tid_, wid = __builtin_amdgcn_readfirstlane(tid >> 6), lane = tid & 63, wr = wid >> 2, wc = wid & 3, fr = lane & 15, fq = lane >> 4;
    const int K = g.K, nt = K / BK;
    unsigned voffA[2], voffB[2];
#pragma unroll
    for (int i = 0; i < 2; ++i) { int R, C; stage_rc(tid * 16 + i * 8192, R, C); const int Rb = Epi::PERM ? ((R & ~31) + perm32(R & 31)) : R;
        voffA[i] = (unsigned)(R * K + C) * 2u; voffB[i] = (unsigned)(Rb * K + C) * 2u; }
    const size_t kstep = (size_t)(BK * 2);
    const size_t hstep = (size_t)HALF * K * 2;
    const size_t tstep = 2 * hstep;
    const unsigned ldsw = (unsigned)wid * 1024u;
    const int aoff = lds_byte(wr * 64 + fr, fq * 8), boff = lds_byte(wc * 32 + fr, fq * 8);
#define PG8_SA(b, h) (((b) * 2 + (h)) * HTB)
#define PG8_SB(b, h) ((4 + (b) * 2 + (h)) * HTB)
#define PG8_STAGE(bufoff, gbase, voff) do { _Pragma("unroll") for (int _i = 0; _i < 2; ++_i) \
        __builtin_amdgcn_global_load_lds((const unsigned*)((const char*)(gbase) + (voff)[_i]), (PG8_LAS unsigned*)(lds + (bufoff) + ldsw + _i * 8192), 16, 0, 0); } while (0)
#define PG8_LDA(dst, b, h) do { _Pragma("unroll") for (int m = 0; m < 4; ++m) _Pragma("unroll") for (int k = 0; k < 2; ++k) dst[m][k] = *(const PG8_LAS bf16x8*)(lds + PG8_SA(b, h) + aoff + m * 2048 + k * 1024); } while (0)
#define PG8_LDB(dst, b, h) do { _Pragma("unroll") for (int n = 0; n < 2; ++n) _Pragma("unroll") for (int k = 0; k < 2; ++k) dst[n][k] = *(const PG8_LAS bf16x8*)(lds + PG8_SB(b, h) + boff + n * 2048 + k * 1024); } while (0)
#define PG8_MMA(ai, bj, At, Bt) do { __builtin_amdgcn_s_setprio(1); _Pragma("unroll") for (int m = 0; m < 4; ++m) _Pragma("unroll") for (int n = 0; n < 2; ++n) _Pragma("unroll") for (int k = 0; k < 2; ++k) \
        acc[ai][bj][m][n] = __builtin_amdgcn_mfma_f32_16x16x32_bf16(Bt[n][k], At[m][k], acc[ai][bj][m][n], 0, 0, 0); __builtin_amdgcn_s_setprio(0); } while (0)
#define PG8_WAIT_V(n) asm volatile("s_waitcnt vmcnt(" #n ")" ::: "memory")
#define PG8_WAIT_L(n) asm volatile("s_waitcnt lgkmcnt(" #n ")" ::: "memory")
#define PG8_BAR __builtin_amdgcn_s_barrier()
#define PG8_SCHED __builtin_amdgcn_sched_barrier(0)
    Unit cur, nxt; int ui = 0;
    if (!S.next(0, cur)) return;
    f32x4 acc[2][2][4][2];
#pragma unroll
    for (int a = 0; a < 2; ++a)
#pragma unroll
        for (int b = 0; b < 2; ++b)
#pragma unroll
            for (int m = 0; m < 4; ++m)
#pragma unroll
                for (int n = 0; n < 2; ++n) acc[a][b][m][n] = (f32x4){0.f, 0.f, 0.f, 0.f};
    bf16x8 At[4][2], B0[2][2], B1[2][2];
    const char* cA = (const char*)g.A + (size_t)cur.pm * tstep; const char* cB = (const char*)g.Bt + (size_t)cur.pn * tstep;
    S.a_ready(cur);
    if constexpr (SP2) {
        PG8_STAGE(PG8_SB(0, 0), cB, voffB); PG8_STAGE(PG8_SB(0, 1), cB + hstep, voffB); PG8_STAGE(PG8_SA(0, 0), cA, voffA); PG8_STAGE(PG8_SA(0, 1), cA + hstep, voffA);
        if (wr == 1) PG8_BAR;
        PG8_WAIT_V(2); PG8_BAR;
        PG8_STAGE(PG8_SB(1, 0), cB + kstep, voffB); PG8_STAGE(PG8_SA(1, 0), cA + kstep, voffA); PG8_STAGE(PG8_SB(1, 1), cB + hstep + kstep, voffB);
        PG8_WAIT_V(6); PG8_BAR;
    } else {
        PG8_STAGE(PG8_SB(0, 0), cB, voffB); PG8_STAGE(PG8_SA(0, 0), cA, voffA); PG8_STAGE(PG8_SB(0, 1), cB + hstep, voffB); PG8_STAGE(PG8_SA(0, 1), cA + hstep, voffA);
        if (wr == 1) PG8_BAR;
        PG8_WAIT_V(4); PG8_BAR;
        PG8_STAGE(PG8_SB(1, 0), cB + kstep, voffB); PG8_STAGE(PG8_SA(1, 0), cA + kstep, voffA); PG8_STAGE(PG8_SB(1, 1), cB + hstep + kstep, voffB);
        PG8_WAIT_V(6); PG8_BAR;
    }
    for (;;) {
        const bool has_next = S.next(ui + 1, nxt);
        const char* nA = has_next ? (const char*)g.A + (size_t)nxt.pm * tstep : cA; const char* nB = has_next ? (const char*)g.Bt + (size_t)nxt.pn * tstep : cB;
        for (int t = 0; t < nt; t += 2) {
            const bool last = (t == nt - 2);
            const char* a1 = cA + (size_t)(t + 1) * kstep;
            const char* a2 = last ? nA : cA + (size_t)(t + 2) * kstep; const char* b2 = last ? nB : cB + (size_t)(t + 2) * kstep;
            const char* a3 = a2 + kstep; const char* b3 = b2 + kstep;
            if (last && has_next) S.a_ready(nxt);
            if constexpr (SP2) {
            PG8_LDB(B0, 0, 0); PG8_LDB(B1, 0, 1); PG8_SCHED; PG8_LDA(At, 0, 0); PG8_STAGE(PG8_SA(1, 1), a1 + hstep, voffA);
            PG8_WAIT_V(8); PG8_WAIT_L(0); PG8_BAR; PG8_MMA(0, 0, At, B0); PG8_MMA(0, 1, At, B1); PG8_BAR; PG8_SCHED;
            PG8_LDA(At, 0, 1); PG8_STAGE(PG8_SB(0, 0), b2, voffB); PG8_STAGE(PG8_SB(0, 1), b2 + hstep, voffB); PG8_STAGE(PG8_SA(0, 0), a2, voffA);
            PG8_WAIT_V(8); PG8_WAIT_L(0); PG8_BAR; PG8_MMA(1, 0, At, B0); PG8_MMA(1, 1, At, B1); PG8_BAR; PG8_SCHED;
            PG8_LDB(B0, 1, 0); PG8_LDB(B1, 1, 1); PG8_SCHED; PG8_LDA(At, 1, 0); PG8_STAGE(PG8_SA(0, 1), a2 + hstep, voffA);
            PG8_WAIT_V(8); PG8_WAIT_L(0); PG8_BAR; PG8_MMA(0, 0, At, B0); PG8_MMA(0, 1, At, B1); PG8_BAR; PG8_SCHED;
            PG8_LDA(At, 1, 1); PG8_STAGE(PG8_SB(1, 0), b3, voffB); PG8_STAGE(PG8_SB(1, 1), b3 + hstep, voffB); PG8_STAGE(PG8_SA(1, 0), a3, voffA);
            PG8_WAIT_V(8); PG8_WAIT_L(0); PG8_BAR; PG8_MMA(1, 0, At, B0); PG8_MMA(1, 1, At, B1); PG8_BAR; PG8_SCHED;
            } else {
            PG8_LDB(B0, 0, 0); PG8_SCHED; PG8_LDA(At, 0, 0); PG8_STAGE(PG8_SA(1, 1), a1 + hstep, voffA);
            PG8_WAIT_L(8); PG8_BAR; PG8_WAIT_L(0); PG8_MMA(0, 0, At, B0); PG8_BAR; PG8_SCHED;
            PG8_LDB(B1, 0, 1); PG8_STAGE(PG8_SB(0, 0), b2, voffB);
            PG8_BAR; PG8_WAIT_L(0); PG8_MMA(0, 1, At, B1); PG8_BAR;
            PG8_LDA(At, 0, 1); PG8_STAGE(PG8_SA(0, 0), a2, voffA);
            PG8_BAR; PG8_WAIT_L(0); PG8_MMA(1, 0, At, B0); PG8_BAR; PG8_SCHED;
            PG8_STAGE(PG8_SB(0, 1), b2 + hstep, voffB);
            PG8_WAIT_V(6); PG8_BAR; PG8_MMA(1, 1, At, B1); PG8_BAR;
            PG8_LDB(B0, 1, 0); PG8_SCHED; PG8_LDA(At, 1, 0); PG8_STAGE(PG8_SA(0, 1), a2 + hstep, voffA);
            PG8_WAIT_L(8); PG8_BAR; PG8_WAIT_L(0); PG8_MMA(0, 0, At, B0); PG8_BAR; PG8_SCHED;
            PG8_LDB(B1, 1, 1); PG8_STAGE(PG8_SB(1, 0), b3, voffB);
            PG8_BAR; PG8_WAIT_L(0); PG8_MMA(0, 1, At, B1); PG8_BAR;
            PG8_LDA(At, 1, 1); PG8_STAGE(PG8_SA(1, 0), a3, voffA);
            PG8_BAR; PG8_WAIT_L(0); PG8_MMA(1, 0, At, B0); PG8_BAR; PG8_SCHED;
            PG8_STAGE(PG8_SB(1, 1), b3 + hstep, voffB);
            PG8_WAIT_V(6); PG8_BAR; PG8_MMA(1, 1, At, B1); PG8_BAR;
            }
        }
        if constexpr (ALIGN_EPI) { if (wr == 0) PG8_BAR; }
        if constexpr (!Epi::AFTER_DRAIN) { E(acc, cur, wr, wc, fr, fq); S.done(cur); }
        if (!has_next) break;
#pragma unroll
        for (int a = 0; a < 2; ++a)
#pragma unroll
            for (int b = 0; b < 2; ++b)
#pragma unroll
                for (int m = 0; m < 4; ++m)
#pragma unroll
                    for (int n = 0; n < 2; ++n) acc[a][b][m][n] = (f32x4){0.f, 0.f, 0.f, 0.f};
        cur = nxt; cA = nA; cB = nB; ++ui;
        if constexpr (ALIGN_EPI) { if (wr == 1) PG8_BAR; }
    }
    PG8_WAIT_V(0);
    if constexpr (!ALIGN_EPI) { if (wr == 0) PG8_BAR; }
    PG8_BAR;
    if constexpr (Epi::AFTER_DRAIN) { E.fused(acc, cur, wr, wc, fr, fq, lds, wid, lane); S.done(cur); }
#undef PG8_SA
#undef PG8_SB
#undef PG8_STAGE
#undef PG8_LDA
#undef PG8_LDB
#undef PG8_MMA
#undef PG8_WAIT_V
#undef PG8_WAIT_L
#undef PG8_BAR
#undef PG8_SCHED
}
}


template <int MODE, int NCG>
__device__ __forceinline__ void phase_gemm_meta(const bf16_t* A, const bf16_t* Bt, int N, void* Cout, const float* H32, float* red, int first_block, const float* lng = nullptr, const float* lnb = nullptr) {
    typedef short bf16x8m __attribute__((ext_vector_type(8)));
    int tid = threadIdx.x; asm volatile("" : "+v"(tid)); const int lane = tid & 63, wave = tid >> 6, fr = lane & 15, fq = lane >> 4;
    const int ntask = N / (16 * NCG), G = gridDim.x, vb = ((int)blockIdx.x - first_block + G) % G;
    for (int g = vb; g < ntask; g += G) {
        const bf16_t* ap = A + (size_t)(MREAL + fr) * DM + wave * 256 + fq * 16;
        const bf16_t* bp = Bt + (size_t)(g * 16 * NCG + fr) * DM + wave * 256 + fq * 16;
        f32x4 acc[NCG][4];
#pragma unroll
        for (int c = 0; c < NCG; ++c)
#pragma unroll
            for (int rg = 0; rg < 4; ++rg) acc[c][rg] = (f32x4){0.f, 0.f, 0.f, 0.f};
#pragma unroll
        for (int s2 = 0; s2 < 4; ++s2) {
            bf16x8m af[4][2], bfr[NCG][2];
#pragma unroll
            for (int c = 0; c < NCG; ++c) { bfr[c][0] = *(const bf16x8m*)(bp + (size_t)c * 16 * DM + s2 * 64); bfr[c][1] = *(const bf16x8m*)(bp + (size_t)c * 16 * DM + s2 * 64 + 8); }
#pragma unroll
            for (int rg = 0; rg < 4; ++rg) { af[rg][0] = *(const bf16x8m*)(ap + (size_t)rg * 16 * DM + s2 * 64); af[rg][1] = *(const bf16x8m*)(ap + (size_t)rg * 16 * DM + s2 * 64 + 8); }
#pragma unroll
            for (int c = 0; c < NCG; ++c)
#pragma unroll
                for (int rg = 0; rg < 4; ++rg) { acc[c][rg] = __builtin_amdgcn_mfma_f32_16x16x32_bf16(af[rg][0], bfr[c][0], acc[c][rg], 0, 0, 0); acc[c][rg] = __builtin_amdgcn_mfma_f32_16x16x32_bf16(af[rg][1], bfr[c][1], acc[c][rg], 0, 0, 0); }
        }
#pragma unroll
        for (int c = 0; c < NCG; ++c)
#pragma unroll
            for (int rg = 0; rg < 4; ++rg)
#pragma unroll
                for (int j = 0; j < 4; ++j) red[(wave * NCG + c) * 1024 + (rg * 4 + j) * 64 + lane] = acc[c][rg][j];
        __syncthreads();
#pragma unroll
        for (int h = 0; h < 2 * NCG; ++h) { const int e = tid + 512 * h, c = e >> 10, e1 = e & 1023, rgj = e1 >> 6, ln = e1 & 63; float v = 0.f;
#pragma unroll
            for (int w = 0; w < 8; ++w) v += red[(w * NCG + c) * 1024 + e1];
            const int R = MREAL + (rgj >> 2) * 16 + (ln >> 4) * 4 + (rgj & 3), col = (g * NCG + c) * 16 + (ln & 15);
            if (MODE == 0) ((bf16_t*)Cout)[(size_t)R * N + col] = (bf16_t)f2bf(col < 2048 ? v * QPRE : v);
            else { float* RES = (float*)Cout; float h = RES[(size_t)R * DM + col];
                if (H32) { const float* st = H32; h = (h - st[2 * R]) * st[2 * R + 1] * lng[col] + lnb[col]; }
                RES[(size_t)R * DM + col] = ALPHA * h + v; } }
        __syncthreads();
    }
}

namespace att {
typedef short bf16x8 __attribute__((ext_vector_type(8)));
typedef short s16x4 __attribute__((ext_vector_type(4)));
typedef float f32x16 __attribute__((ext_vector_type(16)));
typedef unsigned u32x4 __attribute__((ext_vector_type(4)));
constexpr int SHM_V = 16384, SHM_K = 16384, LDS_WS = 2 * SHM_V + 2 * SHM_K, LDS_TBL = LDS_WS + 8 * 64 * 4, LDS_Q = LDS_TBL + 15 * 128 * 4, LDS_BYTES = LDS_Q + 8 * 8192;
constexpr float NEG = -1e30f;
constexpr float THR2 = 8.f;
#define ATT_KSWZ(row, colB) ((row) * 256 + ((colB) ^ (((row) & 7) << 4)))
#define ATT_SBAR() __builtin_amdgcn_sched_barrier(0)
__device__ __forceinline__ constexpr int crow_c(int r) { return (r & 3) + 8 * (r >> 2); }
__device__ __forceinline__ int crow(int r, int hi) { return crow_c(r) + 4 * hi; }
typedef float f32x2_t __attribute__((ext_vector_type(2))); typedef __bf16 bf16x2_t __attribute__((ext_vector_type(2)));
__device__ __forceinline__ unsigned cvtpk(float lo, float hi) { f32x2_t v = {lo, hi}; bf16x2_t b = __builtin_convertvector(v, bf16x2_t); return __builtin_bit_cast(unsigned, b); }

__device__ __forceinline__ void partialSM(f32x16& p0, f32x16& p1, float& m_reg, float& alpha) {
  float pmax = p0[0];
#pragma unroll
  for (int r = 1; r < 16; ++r) pmax = fmaxf(pmax, p0[r]);
#pragma unroll
  for (int r = 0; r < 16; ++r) pmax = fmaxf(pmax, p1[r]);
  { auto rr = __builtin_amdgcn_permlane32_swap(__float_as_uint(pmax), __float_as_uint(pmax), false, false);
    pmax = fmaxf(__uint_as_float(rr[0]), __uint_as_float(rr[1])); }
  float mn;
  if (__builtin_expect(__all(pmax <= m_reg + THR2), 1)) { mn = m_reg; alpha = 1.f; }
  else { mn = fmaxf(m_reg, pmax); alpha = __builtin_amdgcn_exp2f(m_reg - mn); m_reg = mn; }
#pragma unroll
  for (int r = 0; r < 16; ++r) { p0[r] = __builtin_amdgcn_exp2f(p0[r] - mn); p1[r] = p1[r] - mn; }
}
__device__ __forceinline__ void finishSM(f32x16& p0, f32x16& p1, float alpha, float& l_reg, bf16x8& pa0, bf16x8& pa1, bf16x8& pa2, bf16x8& pa3) {
#pragma unroll
  for (int r = 0; r < 16; ++r) p1[r] = __builtin_amdgcn_exp2f(p1[r]);
  float ps = 0;
#pragma unroll
  for (int r = 0; r < 16; ++r) ps += p0[r];
#pragma unroll
  for (int r = 0; r < 16; ++r) ps += p1[r];
  { auto rr = __builtin_amdgcn_permlane32_swap(__float_as_uint(ps), __float_as_uint(ps), false, false);
    ps = __uint_as_float(rr[0]) + __uint_as_float(rr[1]); }
  l_reg = l_reg * alpha + ps;
#define ATT_PK4(P, BASE, OUT) do { unsigned a0 = cvtpk(P[BASE + 0], P[BASE + 1]), a1 = cvtpk(P[BASE + 2], P[BASE + 3]);   \
    unsigned b0 = cvtpk(P[BASE + 4], P[BASE + 5]), b1 = cvtpk(P[BASE + 6], P[BASE + 7]);                              \
    auto r0 = __builtin_amdgcn_permlane32_swap(a0, b0, false, false); auto r1 = __builtin_amdgcn_permlane32_swap(a1, b1, false, false); \
    u32x4 w = {r0[0], r1[0], r0[1], r1[1]}; OUT = *reinterpret_cast<bf16x8*>(&w); } while (0)
  ATT_PK4(p0, 0, pa0); ATT_PK4(p0, 8, pa1); ATT_PK4(p1, 0, pa2); ATT_PK4(p1, 8, pa3);
#undef ATT_PK4
}
template <bool QREG>
__device__ __forceinline__ void qkt(f32x16& p0, f32x16& p1, const char* Ks, const char* qr, const bf16x8* qreg, int r32, int hi) {
  p0 = f32x16{}; p1 = f32x16{};
#pragma unroll
  for (int d0 = 0; d0 < 8; ++d0) { const int cb = (d0 * 16 + hi * 8) * 2;
    const bf16x8 b0 = *reinterpret_cast<const bf16x8*>(Ks + ATT_KSWZ(r32, cb));
    const bf16x8 b1 = *reinterpret_cast<const bf16x8*>(Ks + ATT_KSWZ(32 + r32, cb));
    bf16x8 qf; if constexpr (QREG) qf = qreg[d0]; else qf = *reinterpret_cast<const bf16x8*>(qr + d0 * 1024);
    p0 = __builtin_amdgcn_mfma_f32_32x32x16_bf16(b0, qf, p0, 0, 0, 0);
    p1 = __builtin_amdgcn_mfma_f32_32x32x16_bf16(b1, qf, p1, 0, 0, 0); }
}
__device__ __forceinline__ int v_st(int k, int c) { const int kk = (k & ~0xC) | ((k & 4) << 1) | ((k & 8) >> 1); return ((kk >> 3) * 4 + (c >> 5)) * 512 + ((kk & 7) * 32 + (c & 31)) * 2; }
__device__ __forceinline__ int v_rd_base(int lane) { return ((lane & 3) << 3) | (((lane >> 2) & 3) << 6) | (((lane >> 4) & 1) << 5) | (((lane >> 5) & 1) << 8); }
constexpr int v_rd_off(int d0, int ks, int half) { return d0 * 512 + ks * 4096 + half * 2048; }
typedef short v4i16_t __attribute__((ext_vector_type(4)));
typedef __attribute__((address_space(3))) const char* lds_cptr;
template <int OFF> __device__ __forceinline__ s16x4 tr_read(lds_cptr vb) {
  return __builtin_bit_cast(s16x4, __builtin_amdgcn_ds_read_tr16_b64_v4i16((__attribute__((address_space(3))) v4i16_t*)(vb + OFF)));
}
template <int D0> __device__ __forceinline__ void pv_one(f32x16& od, lds_cptr vb, bf16x8 pa0, bf16x8 pa1, bf16x8 pa2, bf16x8 pa3) {
  const s16x4 l0 = tr_read<v_rd_off(D0, 0, 0)>(vb), h0 = tr_read<v_rd_off(D0, 0, 1)>(vb), l1 = tr_read<v_rd_off(D0, 1, 0)>(vb), h1 = tr_read<v_rd_off(D0, 1, 1)>(vb);
  const s16x4 l2 = tr_read<v_rd_off(D0, 2, 0)>(vb), h2 = tr_read<v_rd_off(D0, 2, 1)>(vb), l3 = tr_read<v_rd_off(D0, 3, 0)>(vb), h3 = tr_read<v_rd_off(D0, 3, 1)>(vb);
#define ATT_PK(L, H) (bf16x8){L[0], L[1], L[2], L[3], H[0], H[1], H[2], H[3]}
  od = __builtin_amdgcn_mfma_f32_32x32x16_bf16(pa0, ATT_PK(l0, h0), od, 0, 0, 0);
  od = __builtin_amdgcn_mfma_f32_32x32x16_bf16(pa1, ATT_PK(l1, h1), od, 0, 0, 0);
  od = __builtin_amdgcn_mfma_f32_32x32x16_bf16(pa2, ATT_PK(l2, h2), od, 0, 0, 0);
  od = __builtin_amdgcn_mfma_f32_32x32x16_bf16(pa3, ATT_PK(l3, h3), od, 0, 0, 0);
#undef ATT_PK
}
__device__ __forceinline__ void pv_d0(f32x16* o, lds_cptr vb, bf16x8 pa0, bf16x8 pa1, bf16x8 pa2, bf16x8 pa3) {
  pv_one<0>(o[0], vb, pa0, pa1, pa2, pa3); pv_one<1>(o[1], vb, pa0, pa1, pa2, pa3); pv_one<2>(o[2], vb, pa0, pa1, pa2, pa3); pv_one<3>(o[3], vb, pa0, pa1, pa2, pa3);
}

#define ATT_PROLOGUE_DECLS \
  const int lane = tid & 63, wid = __builtin_amdgcn_readfirstlane(tid >> 6), r32 = lane & 31, hi = lane >> 5; \
  char* V_lds = lds; char* K_lds = lds + 2 * SHM_V; \
  float* ws = (float*)(lds + LDS_WS) + wid * 64; float* li_l = ws; float* al_l = ws + 32; \
  float m_reg = NEG, l_reg = 0.f; f32x16 o[4] = {}; bf16x8 qreg[8]; char* const qr = lds + LDS_Q + wid * 8192 + lane * 16;     \
  { const bf16_t* Qw = U.qptr(wid, r32) + hi * 8; \
    _Pragma("unroll") for (int d0 = 0; d0 < 8; ++d0) { const bf16x8 qv_ = *reinterpret_cast<const bf16x8*>(Qw + d0 * 16); if constexpr (QREG) qreg[d0] = qv_; else *reinterpret_cast<bf16x8*>(qr + d0 * 1024) = qv_; } } \
  const typename UT::Lane L = U.lane_init(wid, r32, hi); \
  const int sr = tid >> 4, sc = (tid & 15) * 8, vst0 = v_st(sr, sc), vst1 = v_st(32 + sr, sc); \
  const lds_cptr vb0 = (lds_cptr)V_lds + v_rd_base(lane); \
  struct { bf16x8 vs0, vs1, ks0, ks1; } sr_[2]; \
  const int NT = U.NT;
#define ATT_SLOAD(i, t) do { const size_t ra_ = (size_t)U.krow((t), sr) * U.ldp + sc, rb_ = (size_t)U.krow((t), 32 + sr) * U.ldp + sc; \
    sr_[i].vs0 = *reinterpret_cast<const bf16x8*>(U.vbase + ra_); sr_[i].vs1 = *reinterpret_cast<const bf16x8*>(U.vbase + rb_); \
    sr_[i].ks0 = *reinterpret_cast<const bf16x8*>(U.kbase + ra_); sr_[i].ks1 = *reinterpret_cast<const bf16x8*>(U.kbase + rb_); } while (0)
#define ATT_SWRITE(b, i) do { *(bf16x8*)(V_lds + (b) * SHM_V + vst0) = sr_[i].vs0; *(bf16x8*)(V_lds + (b) * SHM_V + vst1) = sr_[i].vs1; const int kc_ = sc * 2; \
    *(bf16x8*)(K_lds + (b) * SHM_K + ATT_KSWZ(sr, kc_)) = sr_[i].ks0; *(bf16x8*)(K_lds + (b) * SHM_K + ATT_KSWZ(32 + sr, kc_)) = sr_[i].ks1; } while (0)
#define ATT_SWAIT() asm volatile("s_waitcnt vmcnt(4)" ::: "memory")
#define ATT_RESC(a) do { if (__any((a) < 1.f)) { if (hi == 0) al_l[r32] = (a); asm volatile("s_waitcnt lgkmcnt(0)" ::: "memory"); \
    _Pragma("unroll") for (int d = 0; d < 4; ++d) _Pragma("unroll") for (int r = 0; r < 16; ++r) o[d][r] *= al_l[crow(r, hi)]; } } while (0)
#define ATT_EPILOGUE \
  l_reg = U.final_l(l_reg, m_reg, wid); \
  if (hi == 0) li_l[r32] = l_reg; asm volatile("s_waitcnt lgkmcnt(0)" ::: "memory"); \
  { float* stg = (float*)(lds + LDS_Q + wid * 8192); \
    _Pragma("unroll") for (int half = 0; half < 2; ++half) { \
      _Pragma("unroll") for (int r8 = 0; r8 < 8; ++r8) { const int r = half * 8 + r8, orow = crow(r, hi); const float rl = __builtin_amdgcn_rcpf(li_l[orow]); \
        _Pragma("unroll") for (int d0 = 0; d0 < 4; ++d0) stg[(orow & 15) * 128 + d0 * 32 + r32] = o[d0][r] * rl; } \
      _Pragma("unroll") for (int i = 0; i < 4; ++i) { const int row16 = i * 4 + (lane >> 4), c8 = (lane & 15) * 8, orow = half * 16 + row16; \
        const f32x4 va = *(const f32x4*)(stg + row16 * 128 + c8), vb = *(const f32x4*)(stg + row16 * 128 + c8 + 4); \
        if (U.row_valid(wid, orow)) U.emit8(wid, orow, c8, va, vb); } } } \
  __syncthreads();

template <class UT, int SD, bool QREG = false>
__device__ __forceinline__ void attn_unit(const UT& U, char* lds, int tid) {
  ATT_PROLOGUE_DECLS
  constexpr int SE = 0, SO = SD - 1;
  U.prep(lds, tid);
  f32x16 pA0, pA1, pB0, pB1; float alA = 1.f, alB = 1.f; bf16x8 pa0, pa1, pa2, pa3;
#define ATT_SWAITD() do { if constexpr (SD == 2) asm volatile("s_waitcnt vmcnt(4)" ::: "memory"); else asm volatile("s_waitcnt vmcnt(0)" ::: "memory"); } while (0)
  ATT_SLOAD(SE, 0); asm volatile("s_waitcnt vmcnt(0)" ::: "memory"); ATT_SWRITE(0, SE); __syncthreads();
  qkt<QREG>(pA0, pA1, K_lds, qr, qreg, r32, hi); U.bias(L, pA0, pA1, 0, hi); partialSM(pA0, pA1, m_reg, alA);
  ATT_SLOAD(SO, 1); if constexpr (SD == 2) { if (2 < NT) ATT_SLOAD(SE, 2); }
  ATT_SWAITD(); ATT_SWRITE(1, SO); __syncthreads();
  for (int j = 1; j + 1 < NT; j += 2) {
    ATT_SBAR(); qkt<QREG>(pB0, pB1, K_lds + SHM_K, qr, qreg, r32, hi);
    finishSM(pA0, pA1, alA, l_reg, pa0, pa1, pa2, pa3); ATT_SBAR();
    if (j + SD < NT) ATT_SLOAD(SO, j + SD); ATT_SBAR();
    pv_d0(o, vb0, pa0, pa1, pa2, pa3);
    U.bias(L, pB0, pB1, j, hi); partialSM(pB0, pB1, m_reg, alB);
    __syncthreads(); ATT_SWAITD(); ATT_SWRITE(0, SE);
    ATT_RESC(alB); __syncthreads();
    ATT_SBAR(); qkt<QREG>(pA0, pA1, K_lds, qr, qreg, r32, hi);
    finishSM(pB0, pB1, alB, l_reg, pa0, pa1, pa2, pa3); ATT_SBAR();
    if (j + 1 + SD < NT) ATT_SLOAD(SE, j + 1 + SD); ATT_SBAR();
    pv_d0(o, vb0 + SHM_V, pa0, pa1, pa2, pa3);
    U.bias(L, pA0, pA1, j + 1, hi); partialSM(pA0, pA1, m_reg, alA);
    __syncthreads(); ATT_SWAITD(); if (j + 2 < NT) ATT_SWRITE(1, SO);
    ATT_RESC(alA); __syncthreads();
  }
  if ((NT & 1) == 0) {
    ATT_SBAR(); qkt<QREG>(pB0, pB1, K_lds + SHM_K, qr, qreg, r32, hi);
    finishSM(pA0, pA1, alA, l_reg, pa0, pa1, pa2, pa3); ATT_SBAR(); pv_d0(o, vb0, pa0, pa1, pa2, pa3);
    U.bias(L, pB0, pB1, NT - 1, hi); partialSM(pB0, pB1, m_reg, alB);
    ATT_RESC(alB);
    finishSM(pB0, pB1, alB, l_reg, pa0, pa1, pa2, pa3); ATT_SBAR(); pv_d0(o, vb0 + SHM_V, pa0, pa1, pa2, pa3);
  } else {
    finishSM(pA0, pA1, alA, l_reg, pa0, pa1, pa2, pa3); ATT_SBAR(); pv_d0(o, vb0, pa0, pa1, pa2, pa3);
  }
#undef ATT_SWAITD
  ATT_EPILOGUE
}

template <class UT, bool QREG = false>
__device__ __forceinline__ void attn_unit_skip(const UT& U, char* lds, int tid) {
  ATT_PROLOGUE_DECLS
  U.prep(lds, tid);
  f32x16 p0, p1; float al; bf16x8 pa0, pa1, pa2, pa3;
#define ATT_COMPUTE(buf) do { qkt<QREG>(p0, p1, K_lds + (buf) * SHM_K, qr, qreg, r32, hi); U.bias(L, p0, p1, tcur, hi); partialSM(p0, p1, m_reg, al); ATT_RESC(al); \
    finishSM(p0, p1, al, l_reg, pa0, pa1, pa2, pa3); ATT_SBAR(); pv_d0(o, vb0 + (buf) * SHM_V, pa0, pa1, pa2, pa3); } while (0)
  ATT_SLOAD(0, 0); asm volatile("s_waitcnt vmcnt(0)" ::: "memory"); ATT_SWRITE(0, 0); if (1 < NT) ATT_SLOAD(1, 1); __syncthreads();
  for (int t = 0; t < NT; t += 2) {
    { const int tcur = t; if (U.active(wid, tcur)) ATT_COMPUTE(0); }
    if (t + 1 < NT) ATT_SWRITE(1, 1);
    if (t + 2 < NT) ATT_SLOAD(0, t + 2);
    __syncthreads();
    if (t + 1 < NT) {
      { const int tcur = t + 1; if (U.active(wid, tcur)) ATT_COMPUTE(1); }
      if (t + 2 < NT) ATT_SWRITE(0, 0);
      if (t + 3 < NT) ATT_SLOAD(1, t + 3);
      __syncthreads();
    }
  }
#undef ATT_COMPUTE
  ATT_EPILOGUE
}

template <class UT, bool QREG = false>
__device__ __forceinline__ void attn_unit_splitk(const UT& U, char* lds, int tid) {
  ATT_PROLOGUE_DECLS
  U.prep(lds, tid);
  f32x16 p0, p1; float al; bf16x8 pa0, pa1, pa2, pa3;
#define ATT_COMPUTE(buf) do { qkt<QREG>(p0, p1, K_lds + (buf) * SHM_K, qr, qreg, r32, hi); U.bias(L, p0, p1, tcur, hi); partialSM(p0, p1, m_reg, al); ATT_RESC(al); \
    finishSM(p0, p1, al, l_reg, pa0, pa1, pa2, pa3); ATT_SBAR(); pv_d0(o, vb0 + (buf) * SHM_V, pa0, pa1, pa2, pa3); } while (0)
  ATT_SLOAD(0, 0); asm volatile("s_waitcnt vmcnt(0)" ::: "memory"); ATT_SWRITE(0, 0); if (1 < NT) ATT_SLOAD(1, 1); __syncthreads();
  for (int t = 0; t < NT; t += 2) {
    { const int tcur = t; if ((tcur & 7) == wid) ATT_COMPUTE(0); }
    if (t + 1 < NT) ATT_SWRITE(1, 1);
    if (t + 2 < NT) ATT_SLOAD(0, t + 2);
    __syncthreads();
    if (t + 1 < NT) {
      { const int tcur = t + 1; if ((tcur & 7) == wid) ATT_COMPUTE(1); }
      if (t + 2 < NT) ATT_SWRITE(0, 0);
      if (t + 3 < NT) ATT_SLOAD(1, t + 3);
      __syncthreads();
    }
  }
#undef ATT_COMPUTE
  float* wsall = (float*)(lds + LDS_WS);
  if (hi == 0) { li_l[r32] = m_reg; al_l[r32] = l_reg; }
  __syncthreads();
  float M = NEG;
#pragma unroll
  for (int w = 0; w < 8; ++w) M = fmaxf(M, wsall[w * 64 + r32]);
  const float fown = __builtin_amdgcn_exp2f(m_reg - M);
  __syncthreads();
  if (hi == 0) li_l[r32] = fown;
  asm volatile("s_waitcnt lgkmcnt(0)" ::: "memory");
  float* osum = (float*)lds;
#pragma unroll
  for (int r = 0; r < 8; ++r) { const int orow = crow(r, hi); const float f = li_l[orow];
#pragma unroll
    for (int d0 = 0; d0 < 4; ++d0) osum[(wid * 16 + orow) * 128 + d0 * 32 + r32] = o[d0][r] * f; }
  __syncthreads();
  { const int row = tid >> 5, c4 = (tid & 31) * 4;
    f32x4 acc = {0.f, 0.f, 0.f, 0.f}; float Lt = 0.f;
#pragma unroll
    for (int w = 0; w < 8; ++w) { acc += *(const f32x4*)(osum + (w * 16 + row) * 128 + c4); Lt += wsall[w * 64 + 32 + row] * wsall[w * 64 + row]; }
    const float rl = 1.f / Lt;
    U.emit4(row, c4, acc * rl); }
  __syncthreads();
}

template <bool META> struct DiffUnitT {
  static constexpr bool meta = META;
  struct Lane { float dq, sl; };
  const bf16_t *P, *kbase, *vbase; bf16_t* OD; int ldp, NT, b, h, j, half, qb;
  __device__ __forceinline__ void init(const unsigned char* ws, int i) {
    P = (const bf16_t*)(ws + WS_P); OD = (bf16_t*)(ws + WS_OD); ldp = 8192; NT = 33;
    int m = meta ? i - 1024 : i >> 3; qb = meta ? 0 : i & 7; half = m & 1; j = (m >> 1) & 1; h = (m >> 2) & 7; b = m >> 5;
    kbase = P + 2048 + h * 256 + j * 128; vbase = P + 4096 + h * 256 + half * 128;
  }
  __device__ __forceinline__ int qrow(int wid, int r) const { return meta ? MREAL + b * 16 + (r & 15) : b * 2048 + qb * 256 + wid * 32 + r; }
  __device__ __forceinline__ const bf16_t* qptr(int wid, int r32) const { return P + (size_t)qrow(wid, r32) * 8192 + h * 256 + j * 128; }
  __device__ __forceinline__ int krow(int t, int i) const { return t < 32 ? b * 2048 + t * 64 + i : MREAL + b * 16 + (i & 15); }
  __device__ __forceinline__ bool active(int wid, int t) const { return !meta || wid == 0; }
  __device__ __forceinline__ Lane lane_init(int wid, int r32, int hi) const {
    Lane L; L.dq = (float)(qb * 256 + wid * 32 + r32 - 4 * hi); L.sl = meta ? 0.f : exp2f(-(float)(h + 1)) * 1.4426950408889634f; return L; }
  __device__ __forceinline__ void bias(const Lane& L, f32x16& p0, f32x16& p1, int t, int hi) const {
    if (t < 32) { const float base = L.dq - 64.f * (float)t;
#pragma unroll
      for (int r = 0; r < 16; ++r) { p0[r] = fmaf(-L.sl, fabsf(base - (float)crow_c(r)), p0[r]); p1[r] = fmaf(-L.sl, fabsf(base - (float)(crow_c(r) + 32)), p1[r]); } }
    else {
#pragma unroll
      for (int r = 0; r < 16; ++r) { if (r >= 8) p0[r] = NEG; p1[r] = NEG; } }
  }
  __device__ __forceinline__ void prep(char* lds, int tid) const {}
  __device__ __forceinline__ float final_l(float l, float m, int wid) const { return l; }
  __device__ __forceinline__ bool row_valid(int wid, int orow) const { return !meta || (wid == 0 && orow < 16); }
  __device__ __forceinline__ void emit(int wid, int orow, int col, float v) const {
    OD[(size_t)qrow(wid, orow) * 4096 + h * 512 + j * 256 + half * 128 + col] = (bf16_t)f2bf(v); }
  __device__ __forceinline__ void emit8(int wid, int orow, int col, f32x4 a, f32x4 c) const {
    u32x4 w; w.x = pk2(a[0], a[1]); w.y = pk2(a[2], a[3]); w.z = pk2(c[0], c[1]); w.w = pk2(c[2], c[3]);
    *(u32x4*)(OD + (size_t)qrow(wid, orow) * 4096 + h * 512 + j * 256 + half * 128 + col) = w; }
  __device__ __forceinline__ void emit4(int row, int col, f32x4 v) const {
    uint2 w; w.x = pk2(v[0], v[1]); w.y = pk2(v[2], v[3]); *(uint2*)(OD + (size_t)(MREAL + b * 16 + row) * 4096 + h * 512 + j * 256 + half * 128 + col) = w; }
};

template <bool META> struct SwaUnitT {
  static constexpr bool meta = META;
  struct Lane { float dq, sl, lo, hi_; };
  const bf16_t *P, *kbase, *vbase; bf16_t* Y; const float* sink; int ldp, NT, b, kvh, s0;
  __device__ __forceinline__ void init(const Params& p, int i) {
    P = (const bf16_t*)(p.ws + WS_P); Y = (bf16_t*)(p.ws + WS_Y); sink = p.sink; ldp = 5120; NT = meta ? 1 : 6;
    const int m = meta ? i : i >> 5; s0 = meta ? 0 : (i & 31) * 64; kvh = m & 3; b = m >> 2;
    kbase = P + 2048 + kvh * 128; vbase = P + 2560 + kvh * 128;
  }
  __device__ __forceinline__ int head(int wid) const { return kvh * 4 + (meta ? (wid & 3) : (wid >> 1)); }
  __device__ __forceinline__ int qrow(int wid, int r) const { return meta ? MREAL + b * 16 + (r & 15) : b * 2048 + s0 + 32 * (wid & 1) + r; }
  __device__ __forceinline__ const bf16_t* qptr(int wid, int r32) const { return P + (size_t)qrow(wid, r32) * 5120 + head(wid) * 128; }
  __device__ __forceinline__ int krow(int t, int i) const {
    if (meta || t == 5) return MREAL + b * 16 + (i & 15);
    const int kp = s0 - 128 + 64 * t + i; return b * 2048 + min(max(kp, 0), 2047); }
  __device__ __forceinline__ bool active(int wid, int t) const { return !meta || wid < 4; }
  __device__ __forceinline__ void prep(char* lds, int tid) const {}
  __device__ __forceinline__ Lane lane_init(int wid, int r32, int hi) const {
    Lane L; const int s = s0 + 32 * (wid & 1) + r32;
    L.dq = (float)(32 * (wid & 1) + r32 + 128 - 4 * hi);
    L.sl = exp2f(-0.5f * (float)(head(wid) + 1)) * 1.4426950408889634f;
    L.lo = (float)max(-128, s - 2047); L.hi_ = (float)min(128, s); return L; }
  __device__ __forceinline__ void bias(const Lane& L, f32x16& p0, f32x16& p1, int t, int hi) const {
    if (!meta && t < 5) { const float base = L.dq - 64.f * (float)t;
#pragma unroll
      for (int r = 0; r < 16; ++r) { const float x0 = base - (float)crow_c(r), x1 = base - (float)(crow_c(r) + 32);
        p0[r] = (x0 >= L.lo && x0 <= L.hi_) ? fmaf(-L.sl, fabsf(x0), p0[r]) : NEG;
        p1[r] = (x1 >= L.lo && x1 <= L.hi_) ? fmaf(-L.sl, fabsf(x1), p1[r]) : NEG; } }
    else {
#pragma unroll
      for (int r = 0; r < 16; ++r) { if (r >= 8) p0[r] = NEG; p1[r] = NEG; } }
  }
  __device__ __forceinline__ float final_l(float l, float m, int wid) const { return l + __builtin_amdgcn_exp2f(sink[head(wid)] * 1.4426950408889634f - m); }
  __device__ __forceinline__ bool row_valid(int wid, int orow) const { return !meta || (wid < 4 && orow < 16); }
  __device__ __forceinline__ void emit(int wid, int orow, int col, float v) const {
    const int R = qrow(wid, orow), hd = head(wid); const float z = bf2f(P[(size_t)R * 5120 + 3072 + hd * 128 + col]);
    Y[(size_t)R * DM + hd * 128 + col] = (bf16_t)f2bf(v * silu(z)); }
  __device__ __forceinline__ void emit8(int wid, int orow, int col, f32x4 a, f32x4 c) const {
    const int R = qrow(wid, orow), hd = head(wid); const u32x4 z = *(const u32x4*)(P + (size_t)R * 5120 + 3072 + hd * 128 + col); u32x4 w;
    w.x = pk2(a[0] * silu(__uint_as_float(z.x << 16)), a[1] * silu(__uint_as_float(z.x & 0xffff0000u))); w.y = pk2(a[2] * silu(__uint_as_float(z.y << 16)), a[3] * silu(__uint_as_float(z.y & 0xffff0000u)));
    w.z = pk2(c[0] * silu(__uint_as_float(z.z << 16)), c[1] * silu(__uint_as_float(z.z & 0xffff0000u))); w.w = pk2(c[2] * silu(__uint_as_float(z.w << 16)), c[3] * silu(__uint_as_float(z.w & 0xffff0000u)));
    *(u32x4*)(Y + (size_t)R * DM + hd * 128 + col) = w; }
};

template <bool META> struct NaUnitT {
  static constexpr bool meta = META;
  struct Lane { const float* tb; int e0; };
  const bf16_t *P, *kbase, *vbase; bf16_t* Y; const float* rpb; float* tbl; int ldp, NT, b, h, u, krA, ntr;
  __device__ __forceinline__ void init(const Params& p, const float* rpb_layer, char* lds, int i) {
    P = (const bf16_t*)(p.ws + WS_P); Y = (bf16_t*)(p.ws + WS_Y); ldp = 8192; tbl = (float*)(lds + LDS_TBL);
    const int m = meta ? i : i >> 3; u = meta ? 0 : i & 7; h = m & 15; b = m >> 4; rpb = rpb_layer + h * 15 * 31;
    krA = min(max(4 * u - 4, 0), 24); const int krB = min(max(4 * u - 1, 0), 24) + 7; ntr = meta ? 0 : krB - krA + 1; NT = ntr + 1;
    kbase = P + 2048 + h * 128; vbase = P + 4096 + h * 128;
  }
  __device__ __forceinline__ int grow(int wid) const { return 4 * u + (wid >> 1); }
  __device__ __forceinline__ int qrow(int wid, int r) const { return meta ? MREAL + b * 16 + (r & 15) : b * 2048 + grow(wid) * 64 + 32 * (wid & 1) + r; }
  __device__ __forceinline__ const bf16_t* qptr(int wid, int r32) const { return P + (size_t)qrow(wid, r32) * 8192 + h * 128; }
  __device__ __forceinline__ int krow(int t, int i) const { return t < ntr ? b * 2048 + (krA + t) * 64 + i : MREAL + b * 16 + (i & 15); }
  __device__ __forceinline__ bool active(int wid, int t) const {
    if (meta) return wid == 0;
    if (t >= ntr) return true;
    const int r0 = min(max(grow(wid) - 4, 0), 24), kr = krA + t; return kr >= r0 && kr <= r0 + 7; }
  __device__ __forceinline__ void prep(char* lds, int tid) const {
    if (!meta) {
#pragma unroll
      for (int k = 0; k < 4; ++k) { const int e = tid + 512 * k; if (e < 15 * 128) { const int dr = e >> 7, dc = (e & 127) - 63;
          tbl[e] = (dc >= -15 && dc <= 15) ? rpb[dr * 31 + dc + 15] * 1.4426950408889634f : NEG; } } }
  }
  __device__ __forceinline__ Lane lane_init(int wid, int r32, int hi) const {
    Lane L; const int c = 32 * (wid & 1) + r32, c0 = min(max(c - 8, 0), 48);
    L.tb = tbl + (7 - grow(wid)) * 128 + (63 - c + 4 * hi);
    L.e0 = 4 * hi - c0; return L; }
  __device__ __forceinline__ void bias(const Lane& L, f32x16& p0, f32x16& p1, int t, int hi) const {
    if (!meta && t < ntr) { const float* tb = L.tb + (krA + t) * 128;
#pragma unroll
      for (int r = 0; r < 16; ++r) {
        p0[r] = ((unsigned)(crow_c(r) + L.e0) < 16u) ? p0[r] + tb[crow_c(r)] : NEG;
        p1[r] = ((unsigned)(crow_c(r) + 32 + L.e0) < 16u) ? p1[r] + tb[crow_c(r) + 32] : NEG; } }
    else {
#pragma unroll
      for (int r = 0; r < 16; ++r) { if (r >= 8) p0[r] = NEG; p1[r] = NEG; } }
  }
  __device__ __forceinline__ float final_l(float l, float m, int wid) const { return l; }
  __device__ __forceinline__ bool row_valid(int wid, int orow) const { return !meta || (wid == 0 && orow < 16); }
  __device__ __forceinline__ void emit(int wid, int orow, int col, float v) const {
    const int R = qrow(wid, orow); const float z = bf2f(P[(size_t)R * 8192 + 6144 + h * 128 + col]);
    Y[(size_t)R * DM + h * 128 + col] = (bf16_t)f2bf(v * silu(z)); }
  __device__ __forceinline__ void emit8(int wid, int orow, int col, f32x4 a, f32x4 c) const {
    const int R = qrow(wid, orow); const u32x4 z = *(const u32x4*)(P + (size_t)R * 8192 + 6144 + h * 128 + col); u32x4 w;
    w.x = pk2(a[0] * silu(__uint_as_float(z.x << 16)), a[1] * silu(__uint_as_float(z.x & 0xffff0000u))); w.y = pk2(a[2] * silu(__uint_as_float(z.y << 16)), a[3] * silu(__uint_as_float(z.y & 0xffff0000u)));
    w.z = pk2(c[0] * silu(__uint_as_float(z.z << 16)), c[1] * silu(__uint_as_float(z.z & 0xffff0000u))); w.w = pk2(c[2] * silu(__uint_as_float(z.w << 16)), c[3] * silu(__uint_as_float(z.w & 0xffff0000u)));
    *(u32x4*)(Y + (size_t)R * DM + h * 128 + col) = w; }
};
}

__device__ __forceinline__ void phase_attn_swa_mfma(const Params& p, char* lds) {
    int tid = threadIdx.x; asm volatile("" : "+v"(tid));
    const int G = gridDim.x, bx = blockIdx.x, vcu = (G % 8 == 0) ? (bx % 8) * (G / 8) + bx / 8 : bx;
    for (int i = vcu; i < 512; i += G) { att::SwaUnitT<false> U; U.init(p, i); att::attn_unit<att::SwaUnitT<false>, 1, true>(U, lds, tid); }
    for (int i = vcu; i < 16; i += G) { att::SwaUnitT<true> U; U.init(p, i); att::attn_unit_skip(U, lds, tid); }
}
__device__ __forceinline__ void phase_attn_na_mfma(const Params& p, const float* rpb_layer, char* lds, bool with_meta) {
    int tid = threadIdx.x; asm volatile("" : "+v"(tid));
    const int G = gridDim.x, bx = blockIdx.x, vcu = (G % 8 == 0) ? (bx % 8) * (G / 8) + bx / 8 : bx;
    for (int i = vcu; i < 512; i += G) { att::NaUnitT<false> U; U.init(p, rpb_layer, lds, i); att::attn_unit_skip(U, lds, tid); }
    if (with_meta) for (int i = vcu; i < 64; i += G) { att::NaUnitT<true> U; U.init(p, rpb_layer, lds, i); att::attn_unit_skip(U, lds, tid); }
}


__device__ __forceinline__ void phase_attn_diff_mfma(const Params& p, char* lds) {
    int tid = threadIdx.x; asm volatile("" : "+v"(tid));
    const int G = gridDim.x, bx = blockIdx.x, vcu = (G % 8 == 0) ? (bx % 8) * (G / 8) + bx / 8 : bx;
    for (int i = vcu; i < 1024; i += G) { att::DiffUnitT<false> U; U.init(p.ws, i); att::attn_unit<att::DiffUnitT<false>, 1, true>(U, lds, tid); }
    if (vcu & 1) { att::DiffUnitT<true> U; U.init(p.ws, 1024 + (vcu >> 1)); att::attn_unit_splitk(U, lds, tid); }
}
__device__ __forceinline__ void phase_diff_combine(const Params& p) {
    int tid = threadIdx.x; asm volatile("" : "+v"(tid)); const int lane = tid & 63, wave = tid >> 6;
    const bf16_t* P = (const bf16_t*)(p.ws + WS_P); const bf16_t* OD = (const bf16_t*)(p.ws + WS_OD); bf16_t* Y = (bf16_t*)(p.ws + WS_Y);
    const int gw = blockIdx.x * NWAVES + wave, NGW = gridDim.x * NWAVES;
    const float l1 = p.lq1[lane] * p.lk1[lane] + p.lq1[lane + 64] * p.lk1[lane + 64], l2 = p.lq2[lane] * p.lk2[lane] + p.lq2[lane + 64] * p.lk2[lane + 64];
    const float lam = __expf(wave_sum(l1)) - __expf(wave_sum(l2)) + LAMBDA_INIT_L1;
    const f32x4 g = *(const f32x4*)(p.subg + 4 * lane);
    constexpr int NT4 = 4;
    for (int task0 = gw; task0 < MTOT * 8; task0 += NT4 * NGW) {
        uint2 a[NT4], c[NT4], zz[NT4]; int Rr[NT4], hh[NT4]; bool ok[NT4];
#pragma unroll
        for (int i = 0; i < NT4; ++i) { int task = task0 + i * NGW; ok[i] = task < MTOT * 8; if (!ok[i]) task = task0; Rr[i] = task >> 3; hh[i] = task & 7;
            a[i] = *(const uint2*)(OD + (size_t)Rr[i] * 4096 + hh[i] * 512 + 4 * lane); c[i] = *(const uint2*)(OD + (size_t)Rr[i] * 4096 + hh[i] * 512 + 256 + 4 * lane);
            zz[i] = *(const uint2*)(P + (size_t)Rr[i] * 8192 + 6144 + hh[i] * 256 + 4 * lane); }
#pragma unroll
        for (int i = 0; i < NT4; ++i) {
            float o[4];
            o[0] = __uint_as_float(a[i].x << 16) - lam * __uint_as_float(c[i].x << 16); o[1] = __uint_as_float(a[i].x & 0xffff0000u) - lam * __uint_as_float(c[i].x & 0xffff0000u);
            o[2] = __uint_as_float(a[i].y << 16) - lam * __uint_as_float(c[i].y << 16); o[3] = __uint_as_float(a[i].y & 0xffff0000u) - lam * __uint_as_float(c[i].y & 0xffff0000u);
            const float ss = wave_sum(o[0] * o[0] + o[1] * o[1] + o[2] * o[2] + o[3] * o[3]);
            const float rinv = 1.f / sqrtf(ss * (1.f / 256.f) + RMS_EPS) * (1.f - LAMBDA_INIT_L1);
            const float y0 = o[0] * rinv * g[0] * silu(__uint_as_float(zz[i].x << 16)), y1 = o[1] * rinv * g[1] * silu(__uint_as_float(zz[i].x & 0xffff0000u));
            const float y2 = o[2] * rinv * g[2] * silu(__uint_as_float(zz[i].y << 16)), y3 = o[3] * rinv * g[3] * silu(__uint_as_float(zz[i].y & 0xffff0000u));
            uint2 ov; ov.x = pk2(y0, y1); ov.y = pk2(y2, y3);
            if (ok[i]) *(uint2*)(Y + (size_t)Rr[i] * DM + hh[i] * 256 + 4 * lane) = ov; }
    }
}

#define RLX_AGENT __ATOMIC_RELAXED, __HIP_MEMORY_SCOPE_AGENT
#define XB_TMO      128
#define XB_XCNT(j)  (256  + 64 * (j))
#define XB_XSUB(j)  (1280 + 64 * (j))
#define XB_XGEN(j)  (2304 + 64 * (j))
#define XB_TOP      3328
#define XB_TOPGEN   3392
#define XCD_BAR_WORDS 3456
#define XB_SPIN_CAP (1u << 18)

__device__ __forceinline__ unsigned xb_ld(unsigned* p)              { return __hip_atomic_load(p, __ATOMIC_RELAXED, __HIP_MEMORY_SCOPE_AGENT); }
__device__ __forceinline__ unsigned xb_add(unsigned* p, unsigned v) { return __hip_atomic_fetch_add(p, v, __ATOMIC_RELAXED, __HIP_MEMORY_SCOPE_AGENT); }
__device__ __forceinline__ unsigned xb_xcc_id() { return (unsigned)__builtin_amdgcn_s_getreg((3 << 11) | 20) & 0xFu; }
#define XB_SPIN(cond, bar) do { unsigned _sp = 0; while (cond) { __builtin_amdgcn_s_sleep(1); \
    if ((++_sp & 255u) == 0u) { if (xb_ld(&(bar)[XB_TMO])) break; if (_sp > XB_SPIN_CAP) { atomicAdd(&(bar)[XB_TMO], 1u); break; } } } } while (0)

struct XcdBarrier {
    unsigned* bar; unsigned x;
    volatile LAS unsigned* st;
};

__device__ __forceinline__ XcdBarrier xcd_barrier_post(unsigned* bar, volatile LAS unsigned* st) {
    XcdBarrier b; b.bar = bar; b.x = xb_xcc_id(); b.st = st;
    if (threadIdx.x == 0) (void)xb_add(&bar[XB_XCNT(b.x)], 1u);
    return b;
}
__device__ __forceinline__ void xcd_barrier_complete(unsigned* bar, unsigned x, unsigned& nloc, unsigned& nx) {
    const unsigned G = gridDim.x * gridDim.y * gridDim.z;
    unsigned sum, cnt, mine, sp = 0u;
    for (;;) {
        sum = 0u; cnt = 0u; mine = 0u;
#pragma unroll
        for (unsigned j = 0; j < 16; ++j) { const unsigned c = xb_ld(&bar[XB_XCNT(j)]); sum += c; cnt += (c > 0u) ? 1u : 0u; mine = (j == x) ? c : mine; }
        if (sum == G) break;
        __builtin_amdgcn_s_sleep(1);
        if ((++sp & 255u) == 0u) { if (xb_ld(&bar[XB_TMO])) break; if (sp > XB_SPIN_CAP) { atomicAdd(&bar[XB_TMO], 1u); break; } }
    }
    nloc = mine > 0u ? mine : 1u; nx = cnt > 0u ? cnt : 1u;
}

__device__ __forceinline__ void xcd_barrier(const XcdBarrier& b) {
    asm volatile("s_waitcnt vmcnt(0)" ::: "memory");
    __syncthreads();
    if (threadIdx.x == 0) {
        unsigned* bar = b.bar;
        __builtin_amdgcn_s_waitcnt(0);
        unsigned nloc = b.st[0], nx = b.st[1];
        if (nloc == 0u) { xcd_barrier_complete(bar, b.x, nloc, nx); b.st[0] = nloc; b.st[1] = nx; }
        const unsigned old = xb_add(&bar[XB_XSUB(b.x)], 1u);
        const unsigned gen = old / nloc;
        if (old + 1u == (gen + 1u) * nloc) {
            __builtin_amdgcn_fence(__ATOMIC_RELEASE, "agent");
            asm volatile("s_waitcnt vmcnt(0)" ::: "memory");
            const unsigned og = xb_add(&bar[XB_TOP], 1u);
            const unsigned tg = og / nx;
            if (og + 1u == (tg + 1u) * nx) xb_add(&bar[XB_TOPGEN], 1u);
            else XB_SPIN(xb_ld(&bar[XB_TOPGEN]) == tg, bar);
            __builtin_amdgcn_fence(__ATOMIC_ACQUIRE, "agent");
            xb_add(&bar[XB_XGEN(b.x)], 1u);
            asm volatile("s_waitcnt vmcnt(0)" ::: "memory");
        } else {
            XB_SPIN(xb_ld(&bar[XB_XGEN(b.x)]) == gen, bar);
            __builtin_amdgcn_fence(__ATOMIC_ACQUIRE, "agent");
            asm volatile("s_waitcnt vmcnt(0)" ::: "memory");
        }
    }
    __syncthreads();
}


#define GRID_SYNC() do { XcdBarrier b_; b_.bar = (unsigned*)(p.ws + WS_CTL); b_.x = xb_xcc_id(); b_.st = (volatile LAS unsigned*)((LAS unsigned char*)lds_raw + LDS_MISC); xcd_barrier(b_); } while (0)
__global__ void __launch_bounds__(NTHREADS, 2) mega(Params p) {
    extern __shared__ __attribute__((aligned(16))) unsigned char lds_raw[];
    float* lds = (float*)lds_raw; PG8_LAS unsigned char* lds3 = (PG8_LAS unsigned char*)lds_raw;
    volatile LAS unsigned* misc = (volatile LAS unsigned*)((LAS unsigned char*)lds_raw + LDS_MISC);
    if (threadIdx.x < 16) misc[threadIdx.x] = 0u;
    __syncthreads();
    (void)xcd_barrier_post((unsigned*)(p.ws + WS_CTL), misc);
    const bf16_t* HB = (const bf16_t*)(p.ws + WS_HB);
    phase_prep(p, lds);
    GRID_SYNC();
    for (int layer = 0; layer < 4; ++layer) {
        const int kind = layer % 3;
        const bf16_t* Wt = (const bf16_t*)(p.ws + (layer == 0 ? WS_WA0 : layer == 1 ? WS_WB : layer == 2 ? WS_WC : WS_WA1));
        { const int N = kind == 2 ? 5120 : 8192; pg8::Gemm g{HB, Wt, MREAL, N, DM}; pg8::StaticOrder S; S.init(MREAL, N, (int)gridDim.x, (int)blockIdx.x);
          pg8::EpiBf16s E{(bf16_t*)(p.ws + WS_P), N, 2048, QPRE};
          pg8::gemm_phase<pg8::EpiBf16s, pg8::StaticOrder, true, true>(lds3, g, S, E);
          phase_gemm_meta<0, 2>(HB, Wt, N, p.ws + WS_P, nullptr, lds, kind == 2 ? 128 : 0); }
        GRID_SYNC();
        if (kind == 0) phase_attn_na_mfma(p, p.rpb_a + (size_t)(layer / 3) * 16 * 15 * 31, (char*)lds_raw, layer < 3);
        else if (kind == 1) { phase_attn_diff_mfma(p, (char*)lds_raw); GRID_SYNC(); phase_diff_combine(p); }
        else phase_attn_swa_mfma(p, (char*)lds_raw);
        GRID_SYNC();
        { pg8::Gemm g{(const bf16_t*)(p.ws + WS_Y), (const bf16_t*)(p.ws + WS_WO) + (size_t)layer * DM * DM, MREAL, DM, DM}; pg8::StaticOrder S; S.init(MREAL, DM, (int)gridDim.x, (int)blockIdx.x);
          const float* lg = layer ? p.ln_g + (layer - 1) * DM : nullptr; const float* lb = layer ? p.ln_b + (layer - 1) * DM : nullptr;
          pg8::EpiResF32 E{(float*)(p.ws + WS_H32), layer == 0 ? p.x : nullptr, (const float*)(p.ws + WS_ST), lg, lb, DM, ALPHA};
          pg8::gemm_phase<pg8::EpiResF32, pg8::StaticOrder, true, true>(lds3, g, S, E);
          if (layer < 3) phase_gemm_meta<1, 1>((const bf16_t*)(p.ws + WS_Y), (const bf16_t*)(p.ws + WS_WO) + (size_t)layer * DM * DM, DM, p.ws + WS_H32, layer ? (const float*)(p.ws + WS_ST) : nullptr, lds, 0, lg, lb); }
        GRID_SYNC();
        phase_ln(p, layer, layer == 3, layer == 3 ? MREAL : MTOT);
        if (layer < 3) GRID_SYNC();
    }
}

extern "C" void kernel_launch(void* const* d_in, const int* in_sizes, int n_in, void* d_out, int out_size, void* d_ws, size_t ws_size, hipStream_t stream) {
    if (n_in != 15 || ws_size < WS_END) { fprintf(stderr, "kernel_launch: unexpected n_in %d or ws_size %zu (< %zu)\n", n_in, ws_size, (size_t)WS_END); return; }
    Params p{};
    p.x = (const float*)d_in[0]; p.meta = (const float*)d_in[1]; p.w_in_a = (const float*)d_in[2]; p.rpb_a = (const float*)d_in[3]; p.w_in_b = (const float*)d_in[4];
    p.lq1 = (const float*)d_in[5]; p.lk1 = (const float*)d_in[6]; p.lq2 = (const float*)d_in[7]; p.lk2 = (const float*)d_in[8]; p.subg = (const float*)d_in[9];
    p.w_in_c = (const float*)d_in[10]; p.sink = (const float*)d_in[11]; p.w_out = (const float*)d_in[12]; p.ln_g = (const float*)d_in[13]; p.ln_b = (const float*)d_in[14];
    p.out = (float*)d_out; p.ws = (unsigned char*)d_ws;
    constexpr int LDSB = LDS_TOTAL;
    static int grid = 0;
    if (grid == 0) {
        int dev = 0, cus = 0, per_cu = 0;
        (void)hipGetDevice(&dev);
        (void)hipDeviceGetAttribute(&cus, hipDeviceAttributeMultiprocessorCount, dev);
        (void)hipFuncSetAttribute((const void*)mega, hipFuncAttributeMaxDynamicSharedMemorySize, LDSB);
        (void)hipOccupancyMaxActiveBlocksPerMultiprocessor(&per_cu, (const void*)mega, NTHREADS, LDSB);
        if (per_cu < 1) fprintf(stderr, "kernel_launch: occupancy query says %d blocks/CU\n", per_cu);
        (void)hipGetLastError();
        grid = cus;
    }
    (void)hipMemsetAsync((char*)d_ws + WS_CTL, 0, CTL_BYTES, stream);
    hipLaunchKernelGGL(mega, dim3(grid), dim3(NTHREADS), LDSB, stream, p);
    const hipError_t le = hipPeekAtLastError();
    if (le != hipSuccess) fprintf(stderr, "kernel_launch: launch failed: %s (grid %d)\n", hipGetErrorName(le), grid);
}
```

```cpp
#include <hip/hip_runtime.h>
#include <cstdio>
#include <cstdint>

#define LAS __attribute__((address_space(3)))
typedef unsigned short bf16_t;
typedef unsigned v4u __attribute__((ext_vector_type(4)));
typedef float f32x4 __attribute__((ext_vector_type(4)));

constexpr int DM = 2048, NBATCH = 4, SEQ = 2048, NMETA = 16;
constexpr int MREAL = NBATCH * SEQ;
constexpr int MTOT = MREAL + NBATCH * NMETA;
constexpr int MPAD = 8448;
constexpr int NWAVES = 8, NTHREADS = 512;
constexpr int LDS_TOTAL = 144 * 1024, LDS_MISC = LDS_TOTAL - 256;
constexpr float LN_EPS = 1e-5f, RMS_EPS = 1e-5f;
constexpr float ALPHA = 1.681792830507429f;
constexpr float QSCALE = 0.6931471805599453f;
constexpr float QPRE = 0.08838834764831845f * 1.4426950408889634f;
constexpr float LAMBDA_INIT_L1 = 0.35550906759096f;

constexpr size_t MiB = 1u << 20;
constexpr size_t WS_WA0 = 0, WS_WA1 = 32 * MiB, WS_WB = 64 * MiB, WS_WC = 96 * MiB, WS_WO = 116 * MiB;
constexpr size_t WS_H32 = 148 * MiB;
constexpr size_t WS_HB = 214 * MiB;
constexpr size_t WS_Y = 247 * MiB;
constexpr size_t WS_P = 280 * MiB;
constexpr size_t WS_PRE = WS_P;
constexpr size_t WS_OD = 412 * MiB;
constexpr size_t WS_CTL = 478 * MiB, CTL_BYTES = 64 * 1024;
constexpr size_t WS_ST = 479 * MiB;
constexpr size_t WS_END = 480 * MiB;

struct Params {
    const float* x; const float* meta; const float* w_in_a; const float* rpb_a; const float* w_in_b;
    const float* lq1; const float* lk1; const float* lq2; const float* lk2; const float* subg;
    const float* w_in_c; const float* sink; const float* w_out; const float* ln_g; const float* ln_b;
    float* out; unsigned char* ws;
};

__device__ __forceinline__ float bf2f(bf16_t v) { return __uint_as_float(((unsigned)v) << 16); }
__device__ __forceinline__ unsigned f2bf(float f) { unsigned u = __float_as_uint(f); return (u + 0x7fffu + ((u >> 16) & 1u)) >> 16; }
__device__ __forceinline__ unsigned pk2(float lo, float hi) { return f2bf(lo) | (f2bf(hi) << 16); }
__device__ __forceinline__ float wave_sum(float v) {
#pragma unroll
    for (int o = 1; o < 64; o <<= 1) v += __shfl_xor(v, o);
    return v;
}
__device__ __forceinline__ float wave_max(float v) {
#pragma unroll
    for (int o = 1; o < 64; o <<= 1) v = fmaxf(v, __shfl_xor(v, o));
    return v;
}
__device__ __forceinline__ float silu(float z) { return z / (1.f + __expf(-z)); }

__device__ __forceinline__ void transpose_item(const float* W, int K, int N, bf16_t* WT, float* scr, int item, int lane) {
    const int nblk = N / 32, kb = item / nblk, nb = item % nblk, k0 = 64 * kb, n0 = 32 * nb;
#pragma unroll 8
    for (int i = 0; i < 32; ++i) { const int kk = 2 * i + (lane >> 5); scr[kk * 33 + (lane & 31)] = W[(size_t)(k0 + kk) * N + n0 + (lane & 31)]; }
    __builtin_amdgcn_s_waitcnt(0); asm volatile("" ::: "memory");
    const int c = lane & 7;
#pragma unroll
    for (int j = 0; j < 4; ++j) { const int n = (lane >> 3) + 8 * j; const float* s = scr + (8 * c) * 33 + n;
        v4u o; o.x = pk2(s[0 * 33], s[1 * 33]); o.y = pk2(s[2 * 33], s[3 * 33]); o.z = pk2(s[4 * 33], s[5 * 33]); o.w = pk2(s[6 * 33], s[7 * 33]);
        *(v4u*)(WT + (size_t)(n0 + n) * K + k0 + 8 * c) = o; }
    __builtin_amdgcn_s_waitcnt(0); asm volatile("" ::: "memory");
}
__device__ __forceinline__ void phase_prep(const Params& p, float* lds) {
    int tid = threadIdx.x; asm volatile("" : "+v"(tid)); const int lane = tid & 63, wave = tid >> 6;
    float* scr = lds + wave * (64 * 33);
    const int gw = blockIdx.x * NWAVES + wave, NGW = gridDim.x * NWAVES;
    constexpr int I_A = 8192, I_C = 5120, I_O = 2048;
    constexpr int NITEMS = 3 * I_A + I_C + 4 * I_O;
    for (int it = gw; it < NITEMS; it += NGW) {
        int r = it;
        if (r < I_A) { transpose_item(p.w_in_a, DM, 8192, (bf16_t*)(p.ws + WS_WA0), scr, r, lane); continue; } r -= I_A;
        if (r < I_A) { transpose_item(p.w_in_a + (size_t)DM * 8192, DM, 8192, (bf16_t*)(p.ws + WS_WA1), scr, r, lane); continue; } r -= I_A;
        if (r < I_A) { transpose_item(p.w_in_b, DM, 8192, (bf16_t*)(p.ws + WS_WB), scr, r, lane); continue; } r -= I_A;
        if (r < I_C) { transpose_item(p.w_in_c, DM, 5120, (bf16_t*)(p.ws + WS_WC), scr, r, lane); continue; } r -= I_C;
        const int li = r / I_O; r -= li * I_O;
        transpose_item(p.w_out + (size_t)li * DM * DM, DM, DM, (bf16_t*)(p.ws + WS_WO) + (size_t)li * DM * DM, scr, r, lane);
    }
    float* H32 = (float*)(p.ws + WS_H32); bf16_t* HB = (bf16_t*)(p.ws + WS_HB);
    for (int R = gw; R < MTOT; R += NGW) {
        const float* src = nullptr;
        if (R < MREAL) src = p.x + (size_t)R * DM; else if (R < MTOT) src = p.meta + (size_t)((R - MREAL) & 15) * DM;
#pragma unroll
        for (int j = 0; j < 8; ++j) {
            const int c = j * 256 + lane * 4;
            f32x4 v = src ? *(const f32x4*)(src + c) : (f32x4){0.f, 0.f, 0.f, 0.f};
            if (R >= MREAL) *(f32x4*)(H32 + (size_t)R * DM + c) = v;
            uint2 o; o.x = pk2(v[0], v[1]); o.y = pk2(v[2], v[3]);
            *(uint2*)(HB + (size_t)R * DM + c) = o;
        }
    }
}

template <int MODE>
__device__ __forceinline__ void phase_gemm_naive(const bf16_t* A, const bf16_t* Bt, int M, int N, int K, void* Cout, const float* H32, float* lds) {
    const int tid = threadIdx.x, ty = tid >> 4, tx = tid & 15;
    float* As = lds;
    float* Bs = lds + 32 * 132;
    const int ntm = M / 128, ntn = N / 64, ntiles = ntm * ntn;
    for (int t = blockIdx.x; t < ntiles; t += gridDim.x) {
        const int tm = t / ntn, tn = t % ntn, m0 = tm * 128, n0 = tn * 64;
        float acc[4][4];
#pragma unroll
        for (int i = 0; i < 4; ++i)
#pragma unroll
            for (int j = 0; j < 4; ++j) acc[i][j] = 0.f;
        for (int k0 = 0; k0 < K; k0 += 32) {
            __syncthreads();
            { const int r = tid >> 2, kc = (tid & 3) * 8; const v4u v = *(const v4u*)(A + (size_t)(m0 + r) * K + k0 + kc);
#pragma unroll
              for (int j = 0; j < 4; ++j) { As[(kc + 2 * j) * 132 + r] = __uint_as_float(v[j] << 16); As[(kc + 2 * j + 1) * 132 + r] = __uint_as_float(v[j] & 0xffff0000u); } }
            if (tid < 256) { const int r = tid >> 2, kc = (tid & 3) * 8; const v4u v = *(const v4u*)(Bt + (size_t)(n0 + r) * K + k0 + kc);
#pragma unroll
              for (int j = 0; j < 4; ++j) { Bs[(kc + 2 * j) * 68 + r] = __uint_as_float(v[j] << 16); Bs[(kc + 2 * j + 1) * 68 + r] = __uint_as_float(v[j] & 0xffff0000u); } }
            __syncthreads();
#pragma unroll 8
            for (int k = 0; k < 32; ++k) {
                const f32x4 a = *(const f32x4*)(As + k * 132 + ty * 4), b = *(const f32x4*)(Bs + k * 68 + tx * 4);
#pragma unroll
                for (int i = 0; i < 4; ++i)
#pragma unroll
                    for (int j = 0; j < 4; ++j) acc[i][j] += a[i] * b[j];
            }
        }
#pragma unroll
        for (int i = 0; i < 4; ++i) {
            const int row = m0 + ty * 4 + i, col = n0 + tx * 4;
            if (MODE == 0) { uint2 o; o.x = pk2(acc[i][0], acc[i][1]); o.y = pk2(acc[i][2], acc[i][3]); *(uint2*)((bf16_t*)Cout + (size_t)row * N + col) = o; }
            else { const f32x4 h = *(const f32x4*)(H32 + (size_t)row * DM + col); f32x4 o;
#pragma unroll
                for (int j = 0; j < 4; ++j) o[j] = ALPHA * h[j] + acc[i][j];
                *(f32x4*)((float*)Cout + (size_t)row * DM + col) = o; }
        }
    }
}

__device__ __forceinline__ float dot128(const float* q, const bf16_t* k) {
    float s = 0.f;
#pragma unroll 4
    for (int c = 0; c < 16; ++c) { const v4u v = *(const v4u*)(k + c * 8);
#pragma unroll
        for (int j = 0; j < 4; ++j) { s += q[c * 8 + 2 * j] * __uint_as_float(v[j] << 16); s += q[c * 8 + 2 * j + 1] * __uint_as_float(v[j] & 0xffff0000u); } }
    return s;
}

__device__ __forceinline__ void phase_attn_na(const Params& p, const float* rpb, float* lds) {
    int tid = threadIdx.x; asm volatile("" : "+v"(tid)); const int lane = tid & 63, wave = tid >> 6;
    float* qs = lds + wave * 512; float* ps = qs + 128;
    const bf16_t* P = (const bf16_t*)(p.ws + WS_P); bf16_t* Y = (bf16_t*)(p.ws + WS_Y);
    const int gw = blockIdx.x * NWAVES + wave, NGW = gridDim.x * NWAVES;
    for (int task = gw; task < MTOT * 16; task += NGW) {
        const int R = task >> 4, h = task & 15;
        const bf16_t* qrow = P + (size_t)R * 8192 + h * 128;
        qs[lane] = bf2f(qrow[lane]); qs[lane + 64] = bf2f(qrow[lane + 64]);
        __builtin_amdgcn_s_waitcnt(0); asm volatile("" ::: "memory");
        int nkeys, b, r = 0, c = 0, r0 = 0, c0 = 0; const bool meta = R >= MREAL;
        if (meta) { b = (R - MREAL) >> 4; nkeys = 16; }
        else { b = R >> 11; const int s = R & 2047; r = s >> 6; c = s & 63; r0 = min(max(r - 4, 0), 24); c0 = min(max(c - 8, 0), 48); nkeys = 144; }
        float sc[3]; float mx = -3.0e38f;
#pragma unroll
        for (int it = 0; it < 3; ++it) {
            const int idx = it * 64 + lane; sc[it] = -3.0e38f;
            if (idx < nkeys) {
                int krow; float bias = 0.f;
                if (idx < 16) krow = MREAL + b * 16 + idx;
                else { const int i = (idx - 16) >> 4, j = (idx - 16) & 15; krow = b * 2048 + (r0 + i) * 64 + (c0 + j);
                       bias = rpb[(h * 15 + (r0 + i - r + 7)) * 31 + (c0 + j - c + 15)]; }
                sc[it] = dot128(qs, P + (size_t)krow * 8192 + 2048 + h * 128) * QSCALE + bias;
            }
            mx = fmaxf(mx, sc[it]);
        }
        mx = wave_max(mx);
        float sum = 0.f;
#pragma unroll
        for (int it = 0; it < 3; ++it) { const int idx = it * 64 + lane; float e = 0.f; if (idx < nkeys) e = __expf(sc[it] - mx); sum += e; if (idx < 192) ps[idx] = e; }
        sum = wave_sum(sum);
        __builtin_amdgcn_s_waitcnt(0); asm volatile("" ::: "memory");
        const float inv = 1.f / sum;
        float o0 = 0.f, o1 = 0.f;
        for (int idx = 0; idx < nkeys; ++idx) {
            int krow;
            if (idx < 16) krow = MREAL + b * 16 + idx;
            else { const int i = (idx - 16) >> 4, j = (idx - 16) & 15; krow = b * 2048 + (r0 + i) * 64 + (c0 + j); }
            const unsigned v = *(const unsigned*)(P + (size_t)krow * 8192 + 4096 + h * 128 + 2 * lane);
            const float pw = ps[idx];
            o0 += pw * __uint_as_float(v << 16); o1 += pw * __uint_as_float(v & 0xffff0000u);
        }
        const unsigned zz = *(const unsigned*)(P + (size_t)R * 8192 + 6144 + h * 128 + 2 * lane);
        const float y0 = o0 * inv * silu(__uint_as_float(zz << 16)), y1 = o1 * inv * silu(__uint_as_float(zz & 0xffff0000u));
        *(unsigned*)(Y + (size_t)R * DM + h * 128 + 2 * lane) = pk2(y0, y1);
        __builtin_amdgcn_s_waitcnt(0); asm volatile("" ::: "memory");
    }
}

__device__ __forceinline__ void phase_attn_diff(const Params& p, float* lds) {
    int tid = threadIdx.x; asm volatile("" : "+v"(tid)); const int lane = tid & 63, wave = tid >> 6;
    float* qs = lds + wave * 4352; float* as = qs + 128; float* tmp = as + 2112;
    const bf16_t* P = (const bf16_t*)(p.ws + WS_P); bf16_t* Y = (bf16_t*)(p.ws + WS_Y);
    const int gw = blockIdx.x * NWAVES + wave, NGW = gridDim.x * NWAVES;
    float l1 = 0.f, l2 = 0.f;
    { l1 = p.lq1[lane] * p.lk1[lane] + p.lq1[lane + 64] * p.lk1[lane + 64]; l2 = p.lq2[lane] * p.lk2[lane] + p.lq2[lane + 64] * p.lk2[lane + 64]; }
    const float lam = __expf(wave_sum(l1)) - __expf(wave_sum(l2)) + LAMBDA_INIT_L1;
    constexpr int LK = 2064, NIT = (LK + 63) / 64;
    for (int task = gw; task < MTOT * 8; task += NGW) {
        const int R = task >> 3, h = task & 7;
        const bool meta = R >= MREAL; const int b = meta ? (R - MREAL) >> 4 : R >> 11; const int s = R & 2047;
        const float slope = exp2f(-(float)(h + 1));
        for (int j = 0; j < 2; ++j) {
            const bf16_t* qrow = P + (size_t)R * 8192 + h * 256 + j * 128;
            __builtin_amdgcn_s_waitcnt(0); asm volatile("" ::: "memory");
            qs[lane] = bf2f(qrow[lane]); qs[lane + 64] = bf2f(qrow[lane + 64]);
            __builtin_amdgcn_s_waitcnt(0); asm volatile("" ::: "memory");
            float mx = -3.0e38f;
            for (int it = 0; it < NIT; ++it) {
                const int idx = it * 64 + lane; float sv = -3.0e38f;
                if (idx < LK) {
                    int krow; float bias = 0.f;
                    if (idx < 16) krow = MREAL + b * 16 + idx;
                    else { const int t = idx - 16; krow = b * 2048 + t; if (!meta) bias = -slope * fabsf((float)(s - t)); }
                    sv = dot128(qs, P + (size_t)krow * 8192 + 2048 + h * 256 + j * 128) * QSCALE + bias;
                }
                tmp[idx] = sv; mx = fmaxf(mx, sv);
            }
            mx = wave_max(mx);
            float sum = 0.f;
            for (int it = 0; it < NIT; ++it) { const int idx = it * 64 + lane; float e = 0.f; if (idx < LK) e = __expf(tmp[idx] - mx); tmp[idx] = e; sum += e; }
            sum = wave_sum(sum);
            const float inv = 1.f / sum;
            for (int it = 0; it < NIT; ++it) { const int idx = it * 64 + lane; if (j == 0) as[idx] = tmp[idx] * inv; else as[idx] -= lam * tmp[idx] * inv; }
        }
        __builtin_amdgcn_s_waitcnt(0); asm volatile("" ::: "memory");
        float o[4] = {0.f, 0.f, 0.f, 0.f};
        for (int idx = 0; idx < LK; ++idx) {
            const int krow = idx < 16 ? MREAL + b * 16 + idx : b * 2048 + idx - 16;
            const uint2 v = *(const uint2*)(P + (size_t)krow * 8192 + 4096 + h * 256 + 4 * lane);
            const float a = as[idx];
            o[0] += a * __uint_as_float(v.x << 16); o[1] += a * __uint_as_float(v.x & 0xffff0000u);
            o[2] += a * __uint_as_float(v.y << 16); o[3] += a * __uint_as_float(v.y & 0xffff0000u);
        }
        const float ss = wave_sum(o[0] * o[0] + o[1] * o[1] + o[2] * o[2] + o[3] * o[3]);
        const float rinv = 1.f / sqrtf(ss * (1.f / 256.f) + RMS_EPS) * (1.f - LAMBDA_INIT_L1);
        const f32x4 g = *(const f32x4*)(p.subg + 4 * lane);
        const uint2 zz = *(const uint2*)(P + (size_t)R * 8192 + 6144 + h * 256 + 4 * lane);
        const float y0 = o[0] * rinv * g[0] * silu(__uint_as_float(zz.x << 16)), y1 = o[1] * rinv * g[1] * silu(__uint_as_float(zz.x & 0xffff0000u));
        const float y2 = o[2] * rinv * g[2] * silu(__uint_as_float(zz.y << 16)), y3 = o[3] * rinv * g[3] * silu(__uint_as_float(zz.y & 0xffff0000u));
        uint2 ov; ov.x = pk2(y0, y1); ov.y = pk2(y2, y3);
        *(uint2*)(Y + (size_t)R * DM + h * 256 + 4 * lane) = ov;
    }
}

__device__ __forceinline__ void phase_attn_swa(const Params& p, float* lds) {
    int tid = threadIdx.x; asm volatile("" : "+v"(tid)); const int lane = tid & 63, wave = tid >> 6;
    float* qs = lds + wave * 512; float* ps = qs + 128;
    const bf16_t* P = (const bf16_t*)(p.ws + WS_P); bf16_t* Y = (bf16_t*)(p.ws + WS_Y);
    const int gw = blockIdx.x * NWAVES + wave, NGW = gridDim.x * NWAVES;
    constexpr int LDP = 5120;
    for (int task = gw; task < MTOT * 16; task += NGW) {
        const int R = task >> 4, hd = task & 15, kh = hd >> 2;
        const bf16_t* qrow = P + (size_t)R * LDP + hd * 128;
        qs[lane] = bf2f(qrow[lane]); qs[lane + 64] = bf2f(qrow[lane + 64]);
        __builtin_amdgcn_s_waitcnt(0); asm volatile("" ::: "memory");
        const bool meta = R >= MREAL; const int b = meta ? (R - MREAL) >> 4 : R >> 11; const int s = R & 2047;
        const int tlo = meta ? 0 : max(s - 128, 0), thi = meta ? -1 : min(s + 128, 2047);
        const int nkeys = 16 + (thi - tlo + 1);
        const float slope = exp2f(-0.5f * (float)(hd + 1)), sinkv = p.sink[hd];
        float sc[5]; float mx = sinkv;
#pragma unroll
        for (int it = 0; it < 5; ++it) {
            const int idx = it * 64 + lane; sc[it] = -3.0e38f;
            if (idx < nkeys) {
                int krow; float bias = 0.f;
                if (idx < 16) krow = MREAL + b * 16 + idx;
                else { const int t = tlo + idx - 16; krow = b * 2048 + t; bias = -slope * fabsf((float)(s - t)); }
                sc[it] = dot128(qs, P + (size_t)krow * LDP + 2048 + kh * 128) * QSCALE + bias;
            }
            mx = fmaxf(mx, sc[it]);
        }
        mx = wave_max(mx);
        float sum = 0.f;
#pragma unroll
        for (int it = 0; it < 5; ++it) { const int idx = it * 64 + lane; float e = 0.f; if (idx < nkeys) e = __expf(sc[it] - mx); sum += e; ps[idx] = e; }
        sum = wave_sum(sum) + __expf(sinkv - mx);
        __builtin_amdgcn_s_waitcnt(0); asm volatile("" ::: "memory");
        const float inv = 1.f / sum;
        float o0 = 0.f, o1 = 0.f;
        for (int idx = 0; idx < nkeys; ++idx) {
            const int krow = idx < 16 ? MREAL + b * 16 + idx : b * 2048 + tlo + idx - 16;
            const unsigned v = *(const unsigned*)(P + (size_t)krow * LDP + 2560 + kh * 128 + 2 * lane);
            const float pw = ps[idx];
            o0 += pw * __uint_as_float(v << 16); o1 += pw * __uint_as_float(v & 0xffff0000u);
        }
        const unsigned zz = *(const unsigned*)(P + (size_t)R * LDP + 3072 + hd * 128 + 2 * lane);
        const float y0 = o0 * inv * silu(__uint_as_float(zz << 16)), y1 = o1 * inv * silu(__uint_as_float(zz & 0xffff0000u));
        *(unsigned*)(Y + (size_t)R * DM + hd * 128 + 2 * lane) = pk2(y0, y1);
        __builtin_amdgcn_s_waitcnt(0); asm volatile("" ::: "memory");
    }
}

__device__ __forceinline__ void phase_ln(const Params& p, int layer, bool last, int nrows) {
    int tid = threadIdx.x; asm volatile("" : "+v"(tid)); const int lane = tid & 63, wave = tid >> 6;
    const int gw = blockIdx.x * NWAVES + wave, NGW = gridDim.x * NWAVES;
    const float* RES = (const float*)(p.ws + WS_H32); float* ST = (float*)(p.ws + WS_ST); bf16_t* HB = (bf16_t*)(p.ws + WS_HB);
    const float* g = p.ln_g + layer * DM; const float* bb = p.ln_b + layer * DM;
    constexpr int NR = 4;
    for (int R0 = gw; R0 < nrows; R0 += NR * NGW) {
        int Rr[NR]; bool ok[NR];
#pragma unroll
        for (int i = 0; i < NR; ++i) { Rr[i] = R0 + i * NGW; ok[i] = Rr[i] < nrows; if (!ok[i]) Rr[i] = R0; }
        f32x4 v[NR][8]; float mean[NR], rstd[NR];
#pragma unroll
        for (int i = 0; i < NR; ++i)
#pragma unroll
            for (int j = 0; j < 8; ++j) v[i][j] = *(const f32x4*)(RES + (size_t)Rr[i] * DM + j * 256 + lane * 4);
#pragma unroll
        for (int i = 0; i < NR; ++i) { float s = 0.f;
#pragma unroll
            for (int j = 0; j < 8; ++j) s += (v[i][j][0] + v[i][j][1]) + (v[i][j][2] + v[i][j][3]);
            mean[i] = wave_sum(s) * (1.f / DM); float q = 0.f;
#pragma unroll
            for (int j = 0; j < 8; ++j) { v[i][j] = v[i][j] - mean[i]; q += (v[i][j][0] * v[i][j][0] + v[i][j][1] * v[i][j][1]) + (v[i][j][2] * v[i][j][2] + v[i][j][3] * v[i][j][3]); }
            rstd[i] = 1.f / sqrtf(wave_sum(q) * (1.f / DM) + LN_EPS);
            if (!last && lane == 0 && ok[i]) { ST[2 * Rr[i]] = mean[i]; ST[2 * Rr[i] + 1] = rstd[i]; } }
#pragma unroll
        for (int j = 0; j < 8; ++j) {
            const int c = j * 256 + lane * 4;
            const f32x4 gg = *(const f32x4*)(g + c), bv = *(const f32x4*)(bb + c);
#pragma unroll
            for (int i = 0; i < NR; ++i) { const f32x4 o = v[i][j] * rstd[i] * gg + bv;
                if (ok[i]) { if (last) *(f32x4*)(p.out + (size_t)Rr[i] * DM + c) = o;
                             else { uint2 w; w.x = pk2(o[0], o[1]); w.y = pk2(o[2], o[3]); *(uint2*)(HB + (size_t)Rr[i] * DM + c) = w; } } }
        }
    }
}

namespace pg8 {
#define PG8_LAS __attribute__((address_space(3)))
typedef unsigned short bf16_t;
typedef short bf16x8 __attribute__((ext_vector_type(8)));
typedef float f32x4 __attribute__((ext_vector_type(4)));
typedef unsigned u32x4 __attribute__((ext_vector_type(4)));
constexpr int BM = 256, BK = 64, HALF = 128, HTB = HALF * BK * 2  , STAGE_BYTES = 8 * HTB, NXCD = 8, WGM = 8;

__host__ __device__ __forceinline__ int lds_byte(int r, int c) { const int st = (r >> 4) * 2 + (c >> 5), rr = r & 15, cc = c & 31, ob = rr * 64 + cc * 2; return st * 1024 + (ob ^ (((ob >> 9) & 1) << 5)); }
__host__ __device__ __forceinline__ void stage_rc(int b, int& R, int& C) { const int st = b / 1024, sb = b % 1024, swz = sb ^ (((sb >> 9) & 1) << 5); R = (st >> 1) * 16 + swz / 64; C = (st & 1) * 32 + (swz % 64) / 2; }
__host__ __device__ __forceinline__ int perm32(int rho) { const int n = rho >> 4, i = rho & 15; return 8 * (i >> 2) + 4 * n + (i & 3); }

struct Unit { int pm, pn; };
struct Gemm { const bf16_t* A; const bf16_t* Bt; int M, N, K; };

struct StaticOrder {
    int nM, nN, nwg, G, c;
    __host__ __device__ void init(int M, int N, int G_, int c_) { nM = M / BM; nN = N / BM; nwg = nM * nN; G = G_; c = c_; }
    __host__ __device__ bool next(int i, Unit& u) const {
        const long L = (long)i * G + c; if (L >= nwg) return false;
        int wgid = (int)L; { const int q = nwg / NXCD, r = nwg % NXCD, xcd = wgid % NXCD, off = wgid / NXCD; wgid = (xcd < r ? xcd * (q + 1) : r * (q + 1) + (xcd - r) * q) + off; }
        const int nig = WGM * nN, gid = wgid / nig, fm = gid * WGM, gsz = (nM - fm) < WGM ? (nM - fm) : WGM;
        u.pm = fm + ((wgid % nig) % gsz); u.pn = (wgid % nig) / gsz; return true;
    }
    __device__ __forceinline__ void a_ready(const Unit&) const {}
    __device__ __forceinline__ void done(const Unit&) const {}
};

typedef float f32x2c __attribute__((ext_vector_type(2))); typedef __bf16 bf16x2c __attribute__((ext_vector_type(2)));
__device__ __forceinline__ unsigned cvt_pk_bf16(float lo, float hi) { f32x2c v = {lo, hi}; bf16x2c b = __builtin_convertvector(v, bf16x2c); return __builtin_bit_cast(unsigned, b); }
typedef float f32x2 __attribute__((ext_vector_type(2)));

struct EpiBf16s {
    static constexpr bool PERM = true, AFTER_DRAIN = false;
    bf16_t* O; int ldc; int qcols; float qscale;
    __device__ __forceinline__ void operator()(const f32x4 (&acc)[2][2][4][2], const Unit& u, int wr, int wc, int fr, int fq) const {
        const int row0 = u.pm * BM + wr * 64 + fr, col0 = u.pn * BM + wc * 32 + 8 * fq; const float sc = (u.pn * BM < qcols) ? qscale : 1.f;
#pragma unroll
        for (int ai = 0; ai < 2; ++ai)
#pragma unroll
            for (int m = 0; m < 4; ++m) { bf16_t* rowp = O + (size_t)(row0 + ai * HALF + m * 16) * ldc + col0;
#pragma unroll
                for (int bj = 0; bj < 2; ++bj) { const f32x4 v0 = acc[ai][bj][m][0] * sc, v1 = acc[ai][bj][m][1] * sc;
                    u32x4 w; w.x = cvt_pk_bf16(v0[0], v0[1]); w.y = cvt_pk_bf16(v0[2], v0[3]); w.z = cvt_pk_bf16(v1[0], v1[1]); w.w = cvt_pk_bf16(v1[2], v1[3]);
                    *(u32x4*)(rowp + bj * HALF) = w; } }
    }
};
struct EpiResF32 {
    static constexpr bool PERM = false, AFTER_DRAIN = false;
    float* RES; const float* xin; const float* st; const float* g; const float* bvec; int ldc; float alpha;
    __device__ __forceinline__ void operator()(const f32x4 (&acc)[2][2][4][2], const Unit& u, int wr, int wc, int fr, int fq) const {
        typedef float f32x2v __attribute__((ext_vector_type(2)));
        const int row0 = u.pm * BM + wr * 64 + fr, col0 = u.pn * BM + wc * 32 + 4 * fq;
        f32x4 gq[2][2], bq[2][2];
#pragma unroll
        for (int bj = 0; bj < 2; ++bj)
#pragma unroll
            for (int n = 0; n < 2; ++n) { if (!xin) { gq[bj][n] = *(const f32x4*)(g + col0 + bj * HALF + n * 16); bq[bj][n] = *(const f32x4*)(bvec + col0 + bj * HALF + n * 16); }
                                          else { gq[bj][n] = (f32x4){1.f, 1.f, 1.f, 1.f}; bq[bj][n] = (f32x4){0.f, 0.f, 0.f, 0.f}; } }
#pragma unroll
        for (int ai = 0; ai < 2; ++ai)
#pragma unroll
            for (int m = 0; m < 4; ++m) { const int row = row0 + ai * HALF + m * 16; const size_t off = (size_t)row * ldc + col0;
                f32x2v sr = {0.f, 1.f}; if (!xin) sr = *(const f32x2v*)(st + 2 * row);
#pragma unroll
                for (int bj = 0; bj < 2; ++bj)
#pragma unroll
                    for (int n = 0; n < 2; ++n) { const size_t o2 = off + bj * HALF + n * 16;
                        f32x4 h;
                        if (xin) h = *(const f32x4*)(xin + o2); else h = (*(const f32x4*)(RES + o2) - sr.x) * sr.y * gq[bj][n] + bq[bj][n];
                        *(f32x4*)(RES + o2) = h * alpha + acc[ai][bj][m][n]; }
                if (m & 1) asm volatile("" ::: "memory"); }
    }
};

template <class Epi, class Sched, bool ALIGN_EPI = false, bool SP2 = false>
__device__ __forceinline__ void gemm_phase(PG8_LAS unsigned char* lds, const Gemm g, const Sched& S, const Epi& E) {
    int tid_ = threadIdx.x; asm volatile("" : "+v"(tid_));
    const int tid = tid_, wid = __builtin_amdgcn_readfirstlane(tid >> 6), lane = tid & 63, wr = wid >> 2, wc = wid & 3, fr = lane & 15, fq = lane >> 4;
    const int K = g.K, nt = K / BK;
    unsigned voffA[2], voffB[2];
#pragma unroll
    for (int i = 0; i < 2; ++i) { int R, C; stage_rc(tid * 16 + i * 8192, R, C); const int Rb = Epi::PERM ? ((R & ~31) + perm32(R & 31)) : R;
        voffA[i] = (unsigned)(R * K + C) * 2u; voffB[i] = (unsigned)(Rb * K + C) * 2u; }
    const size_t kstep = (size_t)(BK * 2);
    const size_t hstep = (size_t)HALF * K * 2;
    const size_t tstep = 2 * hstep;
    const unsigned ldsw = (unsigned)wid * 1024u;
    const int aoff = lds_byte(wr * 64 + fr, fq * 8), boff = lds_byte(wc * 32 + fr, fq * 8);
#define PG8_SA(b, h) (((b) * 2 + (h)) * HTB)
#define PG8_SB(b, h) ((4 + (b) * 2 + (h)) * HTB)
#define PG8_STAGE(bufoff, gbase, voff) do { _Pragma("unroll") for (int _i = 0; _i < 2; ++_i) \
        __builtin_amdgcn_global_load_lds((const unsigned*)((const char*)(gbase) + (voff)[_i]), (PG8_LAS unsigned*)(lds + (bufoff) + ldsw + _i * 8192), 16, 0, 0); } while (0)
#define PG8_LDA(dst, b, h) do { _Pragma("unroll") for (int m = 0; m < 4; ++m) _Pragma("unroll") for (int k = 0; k < 2; ++k) dst[m][k] = *(const PG8_LAS bf16x8*)(lds + PG8_SA(b, h) + aoff + m * 2048 + k * 1024); } while (0)
#define PG8_LDB(dst, b, h) do { _Pragma("unroll") for (int n = 0; n < 2; ++n) _Pragma("unroll") for (int k = 0; k < 2; ++k) dst[n][k] = *(const PG8_LAS bf16x8*)(lds + PG8_SB(b, h) + boff + n * 2048 + k * 1024); } while (0)
#define PG8_MMA(ai, bj, At, Bt) do { __builtin_amdgcn_s_setprio(1); _Pragma("unroll") for (int m = 0; m < 4; ++m) _Pragma("unroll") for (int n = 0; n < 2; ++n) _Pragma("unroll") for (int k = 0; k < 2; ++k) \
        acc[ai][bj][m][n] = __builtin_amdgcn_mfma_f32_16x16x32_bf16(Bt[n][k], At[m][k], acc[ai][bj][m][n], 0, 0, 0); __builtin_amdgcn_s_setprio(0); } while (0)
#define PG8_WAIT_V(n) asm volatile("s_waitcnt vmcnt(" #n ")" ::: "memory")
#define PG8_WAIT_L(n) asm volatile("s_waitcnt lgkmcnt(" #n ")" ::: "memory")
#define PG8_BAR __builtin_amdgcn_s_barrier()
#define PG8_SCHED __builtin_amdgcn_sched_barrier(0)
    Unit cur, nxt; int ui = 0;
    if (!S.next(0, cur)) return;
    f32x4 acc[2][2][4][2];
#pragma unroll
    for (int a = 0; a < 2; ++a)
#pragma unroll
        for (int b = 0; b < 2; ++b)
#pragma unroll
            for (int m = 0; m < 4; ++m)
#pragma unroll
                for (int n = 0; n < 2; ++n) acc[a][b][m][n] = (f32x4){0.f, 0.f, 0.f, 0.f};
    bf16x8 At[4][2], B0[2][2], B1[2][2];
    const char* cA = (const char*)g.A + (size_t)cur.pm * tstep; const char* cB = (const char*)g.Bt + (size_t)cur.pn * tstep;
    S.a_ready(cur);
    if constexpr (SP2) {
        PG8_STAGE(PG8_SB(0, 0), cB, voffB); PG8_STAGE(PG8_SB(0, 1), cB + hstep, voffB); PG8_STAGE(PG8_SA(0, 0), cA, voffA); PG8_STAGE(PG8_SA(0, 1), cA + hstep, voffA);
        if (wr == 1) PG8_BAR;
        PG8_WAIT_V(2); PG8_BAR;
        PG8_STAGE(PG8_SB(1, 0), cB + kstep, voffB); PG8_STAGE(PG8_SA(1, 0), cA + kstep, voffA); PG8_STAGE(PG8_SB(1, 1), cB + hstep + kstep, voffB);
        PG8_WAIT_V(6); PG8_BAR;
    } else {
        PG8_STAGE(PG8_SB(0, 0), cB, voffB); PG8_STAGE(PG8_SA(0, 0), cA, voffA); PG8_STAGE(PG8_SB(0, 1), cB + hstep, voffB); PG8_STAGE(PG8_SA(0, 1), cA + hstep, voffA);
        if (wr == 1) PG8_BAR;
        PG8_WAIT_V(4); PG8_BAR;
        PG8_STAGE(PG8_SB(1, 0), cB + kstep, voffB); PG8_STAGE(PG8_SA(1, 0), cA + kstep, voffA); PG8_STAGE(PG8_SB(1, 1), cB + hstep + kstep, voffB);
        PG8_WAIT_V(6); PG8_BAR;
    }
    for (;;) {
        const bool has_next = S.next(ui + 1, nxt);
        const char* nA = has_next ? (const char*)g.A + (size_t)nxt.pm * tstep : cA; const char* nB = has_next ? (const char*)g.Bt + (size_t)nxt.pn * tstep : cB;
        for (int t = 0; t < nt; t += 2) {
            const bool last = (t == nt - 2);
            const char* a1 = cA + (size_t)(t + 1) * kstep;
            const char* a2 = last ? nA : cA + (size_t)(t + 2) * kstep; const char* b2 = last ? nB : cB + (size_t)(t + 2) * kstep;
            const char* a3 = a2 + kstep; const char* b3 = b2 + kstep;
            if (last && has_next) S.a_ready(nxt);
            if constexpr (SP2) {
            PG8_LDB(B0, 0, 0); PG8_LDB(B1, 0, 1); PG8_SCHED; PG8_LDA(At, 0, 0); PG8_STAGE(PG8_SA(1, 1), a1 + hstep, voffA);
            PG8_WAIT_V(8); PG8_WAIT_L(0); PG8_BAR; PG8_MMA(0, 0, At, B0); PG8_MMA(0, 1, At, B1); PG8_BAR; PG8_SCHED;
            PG8_LDA(At, 0, 1); PG8_STAGE(PG8_SB(0, 0), b2, voffB); PG8_STAGE(PG8_SB(0, 1), b2 + hstep, voffB); PG8_STAGE(PG8_SA(0, 0), a2, voffA);
            PG8_WAIT_V(8); PG8_WAIT_L(0); PG8_BAR; PG8_MMA(1, 0, At, B0); PG8_MMA(1, 1, At, B1); PG8_BAR; PG8_SCHED;
            PG8_LDB(B0, 1, 0); PG8_LDB(B1, 1, 1); PG8_SCHED; PG8_LDA(At, 1, 0); PG8_STAGE(PG8_SA(0, 1), a2 + hstep, voffA);
            PG8_WAIT_V(8); PG8_WAIT_L(0); PG8_BAR; PG8_MMA(0, 0, At, B0); PG8_MMA(0, 1, At, B1); PG8_BAR; PG8_SCHED;
            PG8_LDA(At, 1, 1); PG8_STAGE(PG8_SB(1, 0), b3, voffB); PG8_STAGE(PG8_SB(1, 1), b3 + hstep, voffB); PG8_STAGE(PG8_SA(1, 0), a3, voffA);
            PG8_WAIT_V(8); PG8_WAIT_L(0); PG8_BAR; PG8_MMA(1, 0, At, B0); PG8_MMA(1, 1, At, B1); PG8_BAR; PG8_SCHED;
            } else {
            PG8_LDB(B0, 0, 0); PG8_SCHED; PG8_LDA(At, 0, 0); PG8_STAGE(PG8_SA(1, 1), a1 + hstep, voffA);
            PG8_WAIT_L(8); PG8_BAR; PG8_WAIT_L(0); PG8_MMA(0, 0, At, B0); PG8_BAR; PG8_SCHED;
            PG8_LDB(B1, 0, 1); PG8_STAGE(PG8_SB(0, 0), b2, voffB);
            PG8_BAR; PG8_WAIT_L(0); PG8_MMA(0, 1, At, B1); PG8_BAR;
            PG8_LDA(At, 0, 1); PG8_STAGE(PG8_SA(0, 0), a2, voffA);
            PG8_BAR; PG8_WAIT_L(0); PG8_MMA(1, 0, At, B0); PG8_BAR; PG8_SCHED;
            PG8_STAGE(PG8_SB(0, 1), b2 + hstep, voffB);
            PG8_WAIT_V(6); PG8_BAR; PG8_MMA(1, 1, At, B1); PG8_BAR;
            PG8_LDB(B0, 1, 0); PG8_SCHED; PG8_LDA(At, 1, 0); PG8_STAGE(PG8_SA(0, 1), a2 + hstep, voffA);
            PG8_WAIT_L(8); PG8_BAR; PG8_WAIT_L(0); PG8_MMA(0, 0, At, B0); PG8_BAR; PG8_SCHED;
            PG8_LDB(B1, 1, 1); PG8_STAGE(PG8_SB(1, 0), b3, voffB);
            PG8_BAR; PG8_WAIT_L(0); PG8_MMA(0, 1, At, B1); PG8_BAR;
            PG8_LDA(At, 1, 1); PG8_STAGE(PG8_SA(1, 0), a3, voffA);
            PG8_BAR; PG8_WAIT_L(0); PG8_MMA(1, 0, At, B0); PG8_BAR; PG8_SCHED;
            PG8_STAGE(PG8_SB(1, 1), b3 + hstep, voffB);
            PG8_WAIT_V(6); PG8_BAR; PG8_MMA(1, 1, At, B1); PG8_BAR;
            }
        }
        if constexpr (ALIGN_EPI) { if (wr == 0) PG8_BAR; }
        if constexpr (!Epi::AFTER_DRAIN) { E(acc, cur, wr, wc, fr, fq); S.done(cur); }
        if (!has_next) break;
#pragma unroll
        for (int a = 0; a < 2; ++a)
#pragma unroll
            for (int b = 0; b < 2; ++b)
#pragma unroll
                for (int m = 0; m < 4; ++m)
#pragma unroll
                    for (int n = 0; n < 2; ++n) acc[a][b][m][n] = (f32x4){0.f, 0.f, 0.f, 0.f};
        cur = nxt; cA = nA; cB = nB; ++ui;
        if constexpr (ALIGN_EPI) { if (wr == 1) PG8_BAR; }
    }
    PG8_WAIT_V(0);
    if constexpr (!ALIGN_EPI) { if (wr == 0) PG8_BAR; }
    PG8_BAR;
    if constexpr (Epi::AFTER_DRAIN) { E.fused(acc, cur, wr, wc, fr, fq, lds, wid, lane); S.done(cur); }
#undef PG8_SA
#undef PG8_SB
#undef PG8_STAGE
#undef PG8_LDA
#undef PG8_LDB
#undef PG8_MMA
#undef PG8_WAIT_V
#undef PG8_WAIT_L
#undef PG8_BAR
#undef PG8_SCHED
}
}


template <int MODE, int NCG>
__device__ __forceinline__ void phase_gemm_meta(const bf16_t* A, const bf16_t* Bt, int N, void* Cout, const float* H32, float* red, int first_block, const float* lng = nullptr, const float* lnb = nullptr) {
    typedef short bf16x8m __attribute__((ext_vector_type(8)));
    int tid = threadIdx.x; asm volatile("" : "+v"(tid)); const int lane = tid & 63, wave = tid >> 6, fr = lane & 15, fq = lane >> 4;
    const int ntask = N / (16 * NCG), G = gridDim.x, vb = ((int)blockIdx.x - first_block + G) % G;
    for (int g = vb; g < ntask; g += G) {
        const bf16_t* ap = A + (size_t)(MREAL + fr) * DM + wave * 256 + fq * 16;
        const bf16_t* bp = Bt + (size_t)(g * 16 * NCG + fr) * DM + wave * 256 + fq * 16;
        f32x4 acc[NCG][4];
#pragma unroll
        for (int c = 0; c < NCG; ++c)
#pragma unroll
            for (int rg = 0; rg < 4; ++rg) acc[c][rg] = (f32x4){0.f, 0.f, 0.f, 0.f};
#pragma unroll
        for (int s2 = 0; s2 < 4; ++s2) {
            bf16x8m af[4][2], bfr[NCG][2];
#pragma unroll
            for (int c = 0; c < NCG; ++c) { bfr[c][0] = *(const bf16x8m*)(bp + (size_t)c * 16 * DM + s2 * 64); bfr[c][1] = *(const bf16x8m*)(bp + (size_t)c * 16 * DM + s2 * 64 + 8); }
#pragma unroll
            for (int rg = 0; rg < 4; ++rg) { af[rg][0] = *(const bf16x8m*)(ap + (size_t)rg * 16 * DM + s2 * 64); af[rg][1] = *(const bf16x8m*)(ap + (size_t)rg * 16 * DM + s2 * 64 + 8); }
#pragma unroll
            for (int c = 0; c < NCG; ++c)
#pragma unroll
                for (int rg = 0; rg < 4; ++rg) { acc[c][rg] = __builtin_amdgcn_mfma_f32_16x16x32_bf16(af[rg][0], bfr[c][0], acc[c][rg], 0, 0, 0); acc[c][rg] = __builtin_amdgcn_mfma_f32_16x16x32_bf16(af[rg][1], bfr[c][1], acc[c][rg], 0, 0, 0); }
        }
#pragma unroll
        for (int c = 0; c < NCG; ++c)
#pragma unroll
            for (int rg = 0; rg < 4; ++rg)
#pragma unroll
                for (int j = 0; j < 4; ++j) red[(wave * NCG + c) * 1024 + (rg * 4 + j) * 64 + lane] = acc[c][rg][j];
        __syncthreads();
#pragma unroll
        for (int h = 0; h < 2 * NCG; ++h) { const int e = tid + 512 * h, c = e >> 10, e1 = e & 1023, rgj = e1 >> 6, ln = e1 & 63; float v = 0.f;
#pragma unroll
            for (int w = 0; w < 8; ++w) v += red[(w * NCG + c) * 1024 + e1];
            const int R = MREAL + (rgj >> 2) * 16 + (ln >> 4) * 4 + (rgj & 3), col = (g * NCG + c) * 16 + (ln & 15);
            if (MODE == 0) ((bf16_t*)Cout)[(size_t)R * N + col] = (bf16_t)f2bf(col < 2048 ? v * QPRE : v);
            else { float* RES = (float*)Cout; float h = RES[(size_t)R * DM + col];
                if (H32) { const float* st = H32; h = (h - st[2 * R]) * st[2 * R + 1] * lng[col] + lnb[col]; }
                RES[(size_t)R * DM + col] = ALPHA * h + v; } }
        __syncthreads();
    }
}

namespace att {
typedef short bf16x8 __attribute__((ext_vector_type(8)));
typedef short s16x4 __attribute__((ext_vector_type(4)));
typedef float f32x16 __attribute__((ext_vector_type(16)));
typedef unsigned u32x4 __attribute__((ext_vector_type(4)));
constexpr int SHM_V = 16384, SHM_K = 16384, LDS_WS = 2 * SHM_V + 2 * SHM_K, LDS_TBL = LDS_WS + 8 * 64 * 4, LDS_Q = LDS_TBL + 15 * 128 * 4, LDS_BYTES = LDS_Q + 8 * 8192;
constexpr float NEG = -1e30f;
constexpr float THR2 = 8.f;
#define ATT_KSWZ(row, colB) ((row) * 256 + ((colB) ^ (((row) & 7) << 4)))
#define ATT_SBAR() __builtin_amdgcn_sched_barrier(0)
__device__ __forceinline__ constexpr int crow_c(int r) { return (r & 3) + 8 * (r >> 2); }
__device__ __forceinline__ int crow(int r, int hi) { return crow_c(r) + 4 * hi; }
typedef float f32x2_t __attribute__((ext_vector_type(2))); typedef __bf16 bf16x2_t __attribute__((ext_vector_type(2)));
__device__ __forceinline__ unsigned cvtpk(float lo, float hi) { f32x2_t v = {lo, hi}; bf16x2_t b = __builtin_convertvector(v, bf16x2_t); return __builtin_bit_cast(unsigned, b); }

__device__ __forceinline__ void partialSM(f32x16& p0, f32x16& p1, float& m_reg, float& alpha) {
  float pmax = p0[0];
#pragma unroll
  for (int r = 1; r < 16; ++r) pmax = fmaxf(pmax, p0[r]);
#pragma unroll
  for (int r = 0; r < 16; ++r) pmax = fmaxf(pmax, p1[r]);
  { auto rr = __builtin_amdgcn_permlane32_swap(__float_as_uint(pmax), __float_as_uint(pmax), false, false);
    pmax = fmaxf(__uint_as_float(rr[0]), __uint_as_float(rr[1])); }
  float mn;
  if (__builtin_expect(__all(pmax <= m_reg + THR2), 1)) { mn = m_reg; alpha = 1.f; }
  else { mn = fmaxf(m_reg, pmax); alpha = __builtin_amdgcn_exp2f(m_reg - mn); m_reg = mn; }
#pragma unroll
  for (int r = 0; r < 16; ++r) { p0[r] = __builtin_amdgcn_exp2f(p0[r] - mn); p1[r] = p1[r] - mn; }
}
__device__ __forceinline__ void finishSM(f32x16& p0, f32x16& p1, float alpha, float& l_reg, bf16x8& pa0, bf16x8& pa1, bf16x8& pa2, bf16x8& pa3) {
#pragma unroll
  for (int r = 0; r < 16; ++r) p1[r] = __builtin_amdgcn_exp2f(p1[r]);
  float ps = 0;
#pragma unroll
  for (int r = 0; r < 16; ++r) ps += p0[r];
#pragma unroll
  for (int r = 0; r < 16; ++r) ps += p1[r];
  { auto rr = __builtin_amdgcn_permlane32_swap(__float_as_uint(ps), __float_as_uint(ps), false, false);
    ps = __uint_as_float(rr[0]) + __uint_as_float(rr[1]); }
  l_reg = l_reg * alpha + ps;
#define ATT_PK4(P, BASE, OUT) do { unsigned a0 = cvtpk(P[BASE + 0], P[BASE + 1]), a1 = cvtpk(P[BASE + 2], P[BASE + 3]);   \
    unsigned b0 = cvtpk(P[BASE + 4], P[BASE + 5]), b1 = cvtpk(P[BASE + 6], P[BASE + 7]);                              \
    auto r0 = __builtin_amdgcn_permlane32_swap(a0, b0, false, false); auto r1 = __builtin_amdgcn_permlane32_swap(a1, b1, false, false); \
    u32x4 w = {r0[0], r1[0], r0[1], r1[1]}; OUT = *reinterpret_cast<bf16x8*>(&w); } while (0)
  ATT_PK4(p0, 0, pa0); ATT_PK4(p0, 8, pa1); ATT_PK4(p1, 0, pa2); ATT_PK4(p1, 8, pa3);
#undef ATT_PK4
}
template <bool QREG>
__device__ __forceinline__ void qkt(f32x16& p0, f32x16& p1, const char* Ks, const char* qr, const bf16x8* qreg, int r32, int hi) {
  p0 = f32x16{}; p1 = f32x16{};
  bf16x8 k0[2], k1[2], qf[2];
#define ATT_QLD(d0_, s_) do { const int cb_ = ((d0_) * 16 + hi * 8) * 2; k0[s_] = *reinterpret_cast<const bf16x8*>(Ks + ATT_KSWZ(r32, cb_)); \
    k1[s_] = *reinterpret_cast<const bf16x8*>(Ks + ATT_KSWZ(32 + r32, cb_)); if constexpr (QREG) qf[s_] = qreg[d0_]; else qf[s_] = *reinterpret_cast<const bf16x8*>(qr + (d0_) * 1024); } while (0)
  ATT_QLD(0, 0);
  __builtin_amdgcn_sched_group_barrier(0x100, QREG ? 2 : 3, 0);
#pragma unroll
  for (int d0 = 0; d0 < 8; ++d0) {
    if (d0 < 7) { ATT_QLD(d0 + 1, (d0 + 1) & 1); }
    p0 = __builtin_amdgcn_mfma_f32_32x32x16_bf16(k0[d0 & 1], qf[d0 & 1], p0, 0, 0, 0);
    p1 = __builtin_amdgcn_mfma_f32_32x32x16_bf16(k1[d0 & 1], qf[d0 & 1], p1, 0, 0, 0);
    if (d0 < 7) __builtin_amdgcn_sched_group_barrier(0x100, QREG ? 2 : 3, 0);
    __builtin_amdgcn_sched_group_barrier(0x008, 2, 0);
  }
#undef ATT_QLD
}
__device__ __forceinline__ int v_st(int k, int c) { const int kk = (k & ~0xC) | ((k & 4) << 1) | ((k & 8) >> 1); return ((kk >> 3) * 4 + (c >> 5)) * 512 + ((kk & 7) * 32 + (c & 31)) * 2; }
__device__ __forceinline__ int v_rd_base(int lane) { return ((lane & 3) << 3) | (((lane >> 2) & 3) << 6) | (((lane >> 4) & 1) << 5) | (((lane >> 5) & 1) << 8); }
constexpr int v_rd_off(int d0, int ks, int half) { return d0 * 512 + ks * 4096 + half * 2048; }
typedef short v4i16_t __attribute__((ext_vector_type(4)));
typedef __attribute__((address_space(3))) const char* lds_cptr;
template <int OFF> __device__ __forceinline__ s16x4 tr_read(lds_cptr vb) {
  return __builtin_bit_cast(s16x4, __builtin_amdgcn_ds_read_tr16_b64_v4i16((__attribute__((address_space(3))) v4i16_t*)(vb + OFF)));
}
__device__ __forceinline__ void pv_d0(f32x16* o, lds_cptr vb, bf16x8 pa0, bf16x8 pa1, bf16x8 pa2, bf16x8 pa3) {
  s16x4 vl[2][4], vh[2][4];
#define ATT_VLD(D0, s_) do { vl[s_][0] = tr_read<v_rd_off(D0, 0, 0)>(vb); vh[s_][0] = tr_read<v_rd_off(D0, 0, 1)>(vb); vl[s_][1] = tr_read<v_rd_off(D0, 1, 0)>(vb); vh[s_][1] = tr_read<v_rd_off(D0, 1, 1)>(vb); \
    vl[s_][2] = tr_read<v_rd_off(D0, 2, 0)>(vb); vh[s_][2] = tr_read<v_rd_off(D0, 2, 1)>(vb); vl[s_][3] = tr_read<v_rd_off(D0, 3, 0)>(vb); vh[s_][3] = tr_read<v_rd_off(D0, 3, 1)>(vb); } while (0)
#define ATT_PK(L, H) (bf16x8){L[0], L[1], L[2], L[3], H[0], H[1], H[2], H[3]}
#define ATT_PVM(D0, s_) do { o[D0] = __builtin_amdgcn_mfma_f32_32x32x16_bf16(pa0, ATT_PK(vl[s_][0], vh[s_][0]), o[D0], 0, 0, 0); o[D0] = __builtin_amdgcn_mfma_f32_32x32x16_bf16(pa1, ATT_PK(vl[s_][1], vh[s_][1]), o[D0], 0, 0, 0); \
    o[D0] = __builtin_amdgcn_mfma_f32_32x32x16_bf16(pa2, ATT_PK(vl[s_][2], vh[s_][2]), o[D0], 0, 0, 0); o[D0] = __builtin_amdgcn_mfma_f32_32x32x16_bf16(pa3, ATT_PK(vl[s_][3], vh[s_][3]), o[D0], 0, 0, 0); } while (0)
  ATT_VLD(0, 0); __builtin_amdgcn_sched_group_barrier(0x100, 8, 0);
  ATT_VLD(1, 1); ATT_PVM(0, 0); __builtin_amdgcn_sched_group_barrier(0x100, 8, 0); __builtin_amdgcn_sched_group_barrier(0x008, 4, 0);
  ATT_VLD(2, 0); ATT_PVM(1, 1); __builtin_amdgcn_sched_group_barrier(0x100, 8, 0); __builtin_amdgcn_sched_group_barrier(0x008, 4, 0);
  ATT_VLD(3, 1); ATT_PVM(2, 0); __builtin_amdgcn_sched_group_barrier(0x100, 8, 0); __builtin_amdgcn_sched_group_barrier(0x008, 4, 0);
  ATT_PVM(3, 1); __builtin_amdgcn_sched_group_barrier(0x008, 4, 0);
#undef ATT_VLD
#undef ATT_PK
#undef ATT_PVM
}

#define ATT_PROLOGUE_DECLS \
  const int lane = tid & 63, wid = __builtin_amdgcn_readfirstlane(tid >> 6), r32 = lane & 31, hi = lane >> 5; \
  char* V_lds = lds; char* K_lds = lds + 2 * SHM_V; \
  float* ws = (float*)(lds + LDS_WS) + wid * 64; float* li_l = ws; float* al_l = ws + 32; \
  float m_reg = NEG, l_reg = 0.f; f32x16 o[4] = {}; bf16x8 qreg[8]; char* const qr = lds + LDS_Q + wid * 8192 + lane * 16;     \
  { const bf16_t* Qw = U.qptr(wid, r32) + hi * 8; \
    _Pragma("unroll") for (int d0 = 0; d0 < 8; ++d0) { const bf16x8 qv_ = *reinterpret_cast<const bf16x8*>(Qw + d0 * 16); if constexpr (QREG) qreg[d0] = qv_; else *reinterpret_cast<bf16x8*>(qr + d0 * 1024) = qv_; } } \
  const typename UT::Lane L = U.lane_init(wid, r32, hi); \
  const int sr = tid >> 4, sc = (tid & 15) * 8, vst0 = v_st(sr, sc), vst1 = v_st(32 + sr, sc); \
  const lds_cptr vb0 = (lds_cptr)V_lds + v_rd_base(lane); \
  struct { bf16x8 vs0, vs1, ks0, ks1; } sr_[2]; \
  const int NT = U.NT;
#define ATT_SLOAD(i, t) do { const size_t ra_ = (size_t)U.krow((t), sr) * U.ldp + sc, rb_ = (size_t)U.krow((t), 32 + sr) * U.ldp + sc; \
    sr_[i].vs0 = *reinterpret_cast<const bf16x8*>(U.vbase + ra_); sr_[i].vs1 = *reinterpret_cast<const bf16x8*>(U.vbase + rb_); \
    sr_[i].ks0 = *reinterpret_cast<const bf16x8*>(U.kbase + ra_); sr_[i].ks1 = *reinterpret_cast<const bf16x8*>(U.kbase + rb_); } while (0)
#define ATT_SWRITE(b, i) do { *(bf16x8*)(V_lds + (b) * SHM_V + vst0) = sr_[i].vs0; *(bf16x8*)(V_lds + (b) * SHM_V + vst1) = sr_[i].vs1; const int kc_ = sc * 2; \
    *(bf16x8*)(K_lds + (b) * SHM_K + ATT_KSWZ(sr, kc_)) = sr_[i].ks0; *(bf16x8*)(K_lds + (b) * SHM_K + ATT_KSWZ(32 + sr, kc_)) = sr_[i].ks1; } while (0)
#define ATT_SWAIT() asm volatile("s_waitcnt vmcnt(4)" ::: "memory")
#define ATT_RESC(a) do { if (__any((a) < 1.f)) { if (hi == 0) al_l[r32] = (a); asm volatile("s_waitcnt lgkmcnt(0)" ::: "memory"); \
    _Pragma("unroll") for (int d = 0; d < 4; ++d) _Pragma("unroll") for (int r = 0; r < 16; ++r) o[d][r] *= al_l[crow(r, hi)]; } } while (0)
#define ATT_EPILOGUE \
  l_reg = U.final_l(l_reg, m_reg, wid); \
  if (hi == 0) li_l[r32] = l_reg; asm volatile("s_waitcnt lgkmcnt(0)" ::: "memory"); \
  { float* stg = (float*)(lds + LDS_Q + wid * 8192); \
    _Pragma("unroll") for (int half = 0; half < 2; ++half) { \
      _Pragma("unroll") for (int r8 = 0; r8 < 8; ++r8) { const int r = half * 8 + r8, orow = crow(r, hi); const float rl = __builtin_amdgcn_rcpf(li_l[orow]); \
        _Pragma("unroll") for (int d0 = 0; d0 < 4; ++d0) stg[(orow & 15) * 128 + d0 * 32 + r32] = o[d0][r] * rl; } \
      _Pragma("unroll") for (int i = 0; i < 4; ++i) { const int row16 = i * 4 + (lane >> 4), c8 = (lane & 15) * 8, orow = half * 16 + row16; \
        const f32x4 va = *(const f32x4*)(stg + row16 * 128 + c8), vb = *(const f32x4*)(stg + row16 * 128 + c8 + 4); \
        if (U.row_valid(wid, orow)) U.emit8(wid, orow, c8, va, vb); } } } \
  __syncthreads();

template <class UT, int SD, bool QREG = false>
__device__ __forceinline__ void attn_unit(const UT& U, char* lds, int tid) {
  ATT_PROLOGUE_DECLS
  constexpr int SE = 0, SO = SD - 1;
  U.prep(lds, tid);
  f32x16 pA0, pA1, pB0, pB1; float alA = 1.f, alB = 1.f; bf16x8 pa0, pa1, pa2, pa3;
#define ATT_SWAITD() do { if constexpr (SD == 2) asm volatile("s_waitcnt vmcnt(4)" ::: "memory"); else asm volatile("s_waitcnt vmcnt(0)" ::: "memory"); } while (0)
  ATT_SLOAD(SE, 0); asm volatile("s_waitcnt vmcnt(0)" ::: "memory"); ATT_SWRITE(0, SE); __syncthreads();
  qkt<QREG>(pA0, pA1, K_lds, qr, qreg, r32, hi); U.bias(L, pA0, pA1, 0, hi); partialSM(pA0, pA1, m_reg, alA);
  ATT_SLOAD(SO, 1); if constexpr (SD == 2) { if (2 < NT) ATT_SLOAD(SE, 2); }
  ATT_SWAITD(); ATT_SWRITE(1, SO); __syncthreads();
  for (int j = 1; j + 1 < NT; j += 2) {
    ATT_SBAR(); qkt<QREG>(pB0, pB1, K_lds + SHM_K, qr, qreg, r32, hi);
    finishSM(pA0, pA1, alA, l_reg, pa0, pa1, pa2, pa3); ATT_SBAR();
    if (j + SD < NT) ATT_SLOAD(SO, j + SD); ATT_SBAR();
    pv_d0(o, vb0, pa0, pa1, pa2, pa3);
    U.bias(L, pB0, pB1, j, hi); partialSM(pB0, pB1, m_reg, alB);
    __syncthreads(); ATT_SWAITD(); ATT_SWRITE(0, SE);
    ATT_RESC(alB); __syncthreads();
    ATT_SBAR(); qkt<QREG>(pA0, pA1, K_lds, qr, qreg, r32, hi);
    finishSM(pB0, pB1, alB, l_reg, pa0, pa1, pa2, pa3); ATT_SBAR();
    if (j + 1 + SD < NT) ATT_SLOAD(SE, j + 1 + SD); ATT_SBAR();
    pv_d0(o, vb0 + SHM_V, pa0, pa1, pa2, pa3);
    U.bias(L, pA0, pA1, j + 1, hi); partialSM(pA0, pA1, m_reg, alA);
    __syncthreads(); ATT_SWAITD(); if (j + 2 < NT) ATT_SWRITE(1, SO);
    ATT_RESC(alA); __syncthreads();
  }
  if ((NT & 1) == 0) {
    ATT_SBAR(); qkt<QREG>(pB0, pB1, K_lds + SHM_K, qr, qreg, r32, hi);
    finishSM(pA0, pA1, alA, l_reg, pa0, pa1, pa2, pa3); ATT_SBAR(); pv_d0(o, vb0, pa0, pa1, pa2, pa3);
    U.bias(L, pB0, pB1, NT - 1, hi); partialSM(pB0, pB1, m_reg, alB);
    ATT_RESC(alB);
    finishSM(pB0, pB1, alB, l_reg, pa0, pa1, pa2, pa3); ATT_SBAR(); pv_d0(o, vb0 + SHM_V, pa0, pa1, pa2, pa3);
  } else {
    finishSM(pA0, pA1, alA, l_reg, pa0, pa1, pa2, pa3); ATT_SBAR(); pv_d0(o, vb0, pa0, pa1, pa2, pa3);
  }
#undef ATT_SWAITD
  ATT_EPILOGUE
}

template <class UT, bool QREG = false>
__device__ __forceinline__ void attn_unit_skip(const UT& U, char* lds, int tid) {
  ATT_PROLOGUE_DECLS
  U.prep(lds, tid);
  f32x16 p0, p1; float al; bf16x8 pa0, pa1, pa2, pa3;
#define ATT_COMPUTE(buf) do { qkt<QREG>(p0, p1, K_lds + (buf) * SHM_K, qr, qreg, r32, hi); U.bias(L, p0, p1, tcur, hi); partialSM(p0, p1, m_reg, al); ATT_RESC(al); \
    finishSM(p0, p1, al, l_reg, pa0, pa1, pa2, pa3); ATT_SBAR(); pv_d0(o, vb0 + (buf) * SHM_V, pa0, pa1, pa2, pa3); } while (0)
  ATT_SLOAD(0, 0); asm volatile("s_waitcnt vmcnt(0)" ::: "memory"); ATT_SWRITE(0, 0); if (1 < NT) ATT_SLOAD(1, 1); __syncthreads();
  for (int t = 0; t < NT; t += 2) {
    { const int tcur = t; if (U.active(wid, tcur)) ATT_COMPUTE(0); }
    if (t + 1 < NT) ATT_SWRITE(1, 1);
    if (t + 2 < NT) ATT_SLOAD(0, t + 2);
    __syncthreads();
    if (t + 1 < NT) {
      { const int tcur = t + 1; if (U.active(wid, tcur)) ATT_COMPUTE(1); }
      if (t + 2 < NT) ATT_SWRITE(0, 0);
      if (t + 3 < NT) ATT_SLOAD(1, t + 3);
      __syncthreads();
    }
  }
#undef ATT_COMPUTE
  ATT_EPILOGUE
}

template <class UT, bool QREG = false>
__device__ __forceinline__ void attn_unit_splitk(const UT& U, char* lds, int tid) {
  ATT_PROLOGUE_DECLS
  U.prep(lds, tid);
  f32x16 p0, p1; float al; bf16x8 pa0, pa1, pa2, pa3;
#define ATT_COMPUTE(buf) do { qkt<QREG>(p0, p1, K_lds + (buf) * SHM_K, qr, qreg, r32, hi); U.bias(L, p0, p1, tcur, hi); partialSM(p0, p1, m_reg, al); ATT_RESC(al); \
    finishSM(p0, p1, al, l_reg, pa0, pa1, pa2, pa3); ATT_SBAR(); pv_d0(o, vb0 + (buf) * SHM_V, pa0, pa1, pa2, pa3); } while (0)
  ATT_SLOAD(0, 0); asm volatile("s_waitcnt vmcnt(0)" ::: "memory"); ATT_SWRITE(0, 0); if (1 < NT) ATT_SLOAD(1, 1); __syncthreads();
  for (int t = 0; t < NT; t += 2) {
    { const int tcur = t; if ((tcur & 7) == wid) ATT_COMPUTE(0); }
    if (t + 1 < NT) ATT_SWRITE(1, 1);
    if (t + 2 < NT) ATT_SLOAD(0, t + 2);
    __syncthreads();
    if (t + 1 < NT) {
      { const int tcur = t + 1; if ((tcur & 7) == wid) ATT_COMPUTE(1); }
      if (t + 2 < NT) ATT_SWRITE(0, 0);
      if (t + 3 < NT) ATT_SLOAD(1, t + 3);
      __syncthreads();
    }
  }
#undef ATT_COMPUTE
  float* wsall = (float*)(lds + LDS_WS);
  if (hi == 0) { li_l[r32] = m_reg; al_l[r32] = l_reg; }
  __syncthreads();
  float M = NEG;
#pragma unroll
  for (int w = 0; w < 8; ++w) M = fmaxf(M, wsall[w * 64 + r32]);
  const float fown = __builtin_amdgcn_exp2f(m_reg - M);
  __syncthreads();
  if (hi == 0) li_l[r32] = fown;
  asm volatile("s_waitcnt lgkmcnt(0)" ::: "memory");
  float* osum = (float*)lds;
#pragma unroll
  for (int r = 0; r < 8; ++r) { const int orow = crow(r, hi); const float f = li_l[orow];
#pragma unroll
    for (int d0 = 0; d0 < 4; ++d0) osum[(wid * 16 + orow) * 128 + d0 * 32 + r32] = o[d0][r] * f; }
  __syncthreads();
  { const int row = tid >> 5, c4 = (tid & 31) * 4;
    f32x4 acc = {0.f, 0.f, 0.f, 0.f}; float Lt = 0.f;
#pragma unroll
    for (int w = 0; w < 8; ++w) { acc += *(const f32x4*)(osum + (w * 16 + row) * 128 + c4); Lt += wsall[w * 64 + 32 + row] * wsall[w * 64 + row]; }
    const float rl = 1.f / Lt;
    U.emit4(row, c4, acc * rl); }
  __syncthreads();
}

template <bool META> struct DiffUnitT {
  static constexpr bool meta = META;
  struct Lane { float dq, sl; };
  const bf16_t *P, *kbase, *vbase; bf16_t* OD; int ldp, NT, b, h, j, half, qb;
  __device__ __forceinline__ void init(const unsigned char* ws, int i) {
    P = (const bf16_t*)(ws + WS_P); OD = (bf16_t*)(ws + WS_OD); ldp = 8192; NT = 33;
    int m = meta ? i - 1024 : i >> 3; qb = meta ? 0 : i & 7; half = m & 1; j = (m >> 1) & 1; h = (m >> 2) & 7; b = m >> 5;
    kbase = P + 2048 + h * 256 + j * 128; vbase = P + 4096 + h * 256 + half * 128;
  }
  __device__ __forceinline__ int qrow(int wid, int r) const { return meta ? MREAL + b * 16 + (r & 15) : b * 2048 + qb * 256 + wid * 32 + r; }
  __device__ __forceinline__ const bf16_t* qptr(int wid, int r32) const { return P + (size_t)qrow(wid, r32) * 8192 + h * 256 + j * 128; }
  __device__ __forceinline__ int krow(int t, int i) const { return t < 32 ? b * 2048 + t * 64 + i : MREAL + b * 16 + (i & 15); }
  __device__ __forceinline__ bool active(int wid, int t) const { return !meta || wid == 0; }
  __device__ __forceinline__ Lane lane_init(int wid, int r32, int hi) const {
    Lane L; L.dq = (float)(qb * 256 + wid * 32 + r32 - 4 * hi); L.sl = meta ? 0.f : exp2f(-(float)(h + 1)) * 1.4426950408889634f; return L; }
  __device__ __forceinline__ void bias(const Lane& L, f32x16& p0, f32x16& p1, int t, int hi) const {
    if (t < 32) { const float base = L.dq - 64.f * (float)t;
#pragma unroll
      for (int r = 0; r < 16; ++r) { p0[r] = fmaf(-L.sl, fabsf(base - (float)crow_c(r)), p0[r]); p1[r] = fmaf(-L.sl, fabsf(base - (float)(crow_c(r) + 32)), p1[r]); } }
    else {
#pragma unroll
      for (int r = 0; r < 16; ++r) { if (r >= 8) p0[r] = NEG; p1[r] = NEG; } }
  }
  __device__ __forceinline__ void prep(char* lds, int tid) const {}
  __device__ __forceinline__ float final_l(float l, float m, int wid) const { return l; }
  __device__ __forceinline__ bool row_valid(int wid, int orow) const { return !meta || (wid == 0 && orow < 16); }
  __device__ __forceinline__ void emit(int wid, int orow, int col, float v) const {
    OD[(size_t)qrow(wid, orow) * 4096 + h * 512 + j * 256 + half * 128 + col] = (bf16_t)f2bf(v); }
  __device__ __forceinline__ void emit8(int wid, int orow, int col, f32x4 a, f32x4 c) const {
    u32x4 w; w.x = pk2(a[0], a[1]); w.y = pk2(a[2], a[3]); w.z = pk2(c[0], c[1]); w.w = pk2(c[2], c[3]);
    *(u32x4*)(OD + (size_t)qrow(wid, orow) * 4096 + h * 512 + j * 256 + half * 128 + col) = w; }
  __device__ __forceinline__ void emit4(int row, int col, f32x4 v) const {
    uint2 w; w.x = pk2(v[0], v[1]); w.y = pk2(v[2], v[3]); *(uint2*)(OD + (size_t)(MREAL + b * 16 + row) * 4096 + h * 512 + j * 256 + half * 128 + col) = w; }
};

template <bool META> struct SwaUnitT {
  static constexpr bool meta = META;
  struct Lane { float dq, sl, lo, hi_; };
  const bf16_t *P, *kbase, *vbase; bf16_t* Y; const float* sink; int ldp, NT, b, kvh, s0;
  __device__ __forceinline__ void init(const Params& p, int i) {
    P = (const bf16_t*)(p.ws + WS_P); Y = (bf16_t*)(p.ws + WS_Y); sink = p.sink; ldp = 5120; NT = meta ? 1 : 6;
    const int m = meta ? i : i >> 5; s0 = meta ? 0 : (i & 31) * 64; kvh = m & 3; b = m >> 2;
    kbase = P + 2048 + kvh * 128; vbase = P + 2560 + kvh * 128;
  }
  __device__ __forceinline__ int head(int wid) const { return kvh * 4 + (meta ? (wid & 3) : (wid >> 1)); }
  __device__ __forceinline__ int qrow(int wid, int r) const { return meta ? MREAL + b * 16 + (r & 15) : b * 2048 + s0 + 32 * (wid & 1) + r; }
  __device__ __forceinline__ const bf16_t* qptr(int wid, int r32) const { return P + (size_t)qrow(wid, r32) * 5120 + head(wid) * 128; }
  __device__ __forceinline__ int krow(int t, int i) const {
    if (meta || t == 5) return MREAL + b * 16 + (i & 15);
    const int kp = s0 - 128 + 64 * t + i; return b * 2048 + min(max(kp, 0), 2047); }
  __device__ __forceinline__ bool active(int wid, int t) const { return !meta || wid < 4; }
  __device__ __forceinline__ void prep(char* lds, int tid) const {}
  __device__ __forceinline__ Lane lane_init(int wid, int r32, int hi) const {
    Lane L; const int s = s0 + 32 * (wid & 1) + r32;
    L.dq = (float)(32 * (wid & 1) + r32 + 128 - 4 * hi);
    L.sl = exp2f(-0.5f * (float)(head(wid) + 1)) * 1.4426950408889634f;
    L.lo = (float)max(-128, s - 2047); L.hi_ = (float)min(128, s); return L; }
  __device__ __forceinline__ void bias(const Lane& L, f32x16& p0, f32x16& p1, int t, int hi) const {
    if (!meta && t < 5) { const float base = L.dq - 64.f * (float)t;
#pragma unroll
      for (int r = 0; r < 16; ++r) { const float x0 = base - (float)crow_c(r), x1 = base - (float)(crow_c(r) + 32);
        p0[r] = (x0 >= L.lo && x0 <= L.hi_) ? fmaf(-L.sl, fabsf(x0), p0[r]) : NEG;
        p1[r] = (x1 >= L.lo && x1 <= L.hi_) ? fmaf(-L.sl, fabsf(x1), p1[r]) : NEG; } }
    else {
#pragma unroll
      for (int r = 0; r < 16; ++r) { if (r >= 8) p0[r] = NEG; p1[r] = NEG; } }
  }
  __device__ __forceinline__ float final_l(float l, float m, int wid) const { return l + __builtin_amdgcn_exp2f(sink[head(wid)] * 1.4426950408889634f - m); }
  __device__ __forceinline__ bool row_valid(int wid, int orow) const { return !meta || (wid < 4 && orow < 16); }
  __device__ __forceinline__ void emit(int wid, int orow, int col, float v) const {
    const int R = qrow(wid, orow), hd = head(wid); const float z = bf2f(P[(size_t)R * 5120 + 3072 + hd * 128 + col]);
    Y[(size_t)R * DM + hd * 128 + col] = (bf16_t)f2bf(v * silu(z)); }
  __device__ __forceinline__ void emit8(int wid, int orow, int col, f32x4 a, f32x4 c) const {
    const int R = qrow(wid, orow), hd = head(wid); const u32x4 z = *(const u32x4*)(P + (size_t)R * 5120 + 3072 + hd * 128 + col); u32x4 w;
    w.x = pk2(a[0] * silu(__uint_as_float(z.x << 16)), a[1] * silu(__uint_as_float(z.x & 0xffff0000u))); w.y = pk2(a[2] * silu(__uint_as_float(z.y << 16)), a[3] * silu(__uint_as_float(z.y & 0xffff0000u)));
    w.z = pk2(c[0] * silu(__uint_as_float(z.z << 16)), c[1] * silu(__uint_as_float(z.z & 0xffff0000u))); w.w = pk2(c[2] * silu(__uint_as_float(z.w << 16)), c[3] * silu(__uint_as_float(z.w & 0xffff0000u)));
    *(u32x4*)(Y + (size_t)R * DM + hd * 128 + col) = w; }
};

template <bool META> struct NaUnitT {
  static constexpr bool meta = META;
  struct Lane { const float* tb; int e0; };
  const bf16_t *P, *kbase, *vbase; bf16_t* Y; const float* rpb; float* tbl; int ldp, NT, b, h, u, krA, ntr;
  __device__ __forceinline__ void init(const Params& p, const float* rpb_layer, char* lds, int i) {
    P = (const bf16_t*)(p.ws + WS_P); Y = (bf16_t*)(p.ws + WS_Y); ldp = 8192; tbl = (float*)(lds + LDS_TBL);
    const int m = meta ? i : i >> 3; u = meta ? 0 : i & 7; h = m & 15; b = m >> 4; rpb = rpb_layer + h * 15 * 31;
    krA = min(max(4 * u - 4, 0), 24); const int krB = min(max(4 * u - 1, 0), 24) + 7; ntr = meta ? 0 : krB - krA + 1; NT = ntr + 1;
    kbase = P + 2048 + h * 128; vbase = P + 4096 + h * 128;
  }
  __device__ __forceinline__ int grow(int wid) const { return 4 * u + (wid >> 1); }
  __device__ __forceinline__ int qrow(int wid, int r) const { return meta ? MREAL + b * 16 + (r & 15) : b * 2048 + grow(wid) * 64 + 32 * (wid & 1) + r; }
  __device__ __forceinline__ const bf16_t* qptr(int wid, int r32) const { return P + (size_t)qrow(wid, r32) * 8192 + h * 128; }
  __device__ __forceinline__ int krow(int t, int i) const { return t < ntr ? b * 2048 + (krA + t) * 64 + i : MREAL + b * 16 + (i & 15); }
  __device__ __forceinline__ bool active(int wid, int t) const {
    if (meta) return wid == 0;
    if (t >= ntr) return true;
    const int r0 = min(max(grow(wid) - 4, 0), 24), kr = krA + t; return kr >= r0 && kr <= r0 + 7; }
  __device__ __forceinline__ void prep(char* lds, int tid) const {
    if (!meta) {
#pragma unroll
      for (int k = 0; k < 4; ++k) { const int e = tid + 512 * k; if (e < 15 * 128) { const int dr = e >> 7, dc = (e & 127) - 63;
          tbl[e] = (dc >= -15 && dc <= 15) ? rpb[dr * 31 + dc + 15] * 1.4426950408889634f : NEG; } } }
  }
  __device__ __forceinline__ Lane lane_init(int wid, int r32, int hi) const {
    Lane L; const int c = 32 * (wid & 1) + r32, c0 = min(max(c - 8, 0), 48);
    L.tb = tbl + (7 - grow(wid)) * 128 + (63 - c + 4 * hi);
    L.e0 = 4 * hi - c0; return L; }
  __device__ __forceinline__ void bias(const Lane& L, f32x16& p0, f32x16& p1, int t, int hi) const {
    if (!meta && t < ntr) { const float* tb = L.tb + (krA + t) * 128;
#pragma unroll
      for (int r = 0; r < 16; ++r) {
        p0[r] = ((unsigned)(crow_c(r) + L.e0) < 16u) ? p0[r] + tb[crow_c(r)] : NEG;
        p1[r] = ((unsigned)(crow_c(r) + 32 + L.e0) < 16u) ? p1[r] + tb[crow_c(r) + 32] : NEG; } }
    else {
#pragma unroll
      for (int r = 0; r < 16; ++r) { if (r >= 8) p0[r] = NEG; p1[r] = NEG; } }
  }
  __device__ __forceinline__ float final_l(float l, float m, int wid) const { return l; }
  __device__ __forceinline__ bool row_valid(int wid, int orow) const { return !meta || (wid == 0 && orow < 16); }
  __device__ __forceinline__ void emit(int wid, int orow, int col, float v) const {
    const int R = qrow(wid, orow); const float z = bf2f(P[(size_t)R * 8192 + 6144 + h * 128 + col]);
    Y[(size_t)R * DM + h * 128 + col] = (bf16_t)f2bf(v * silu(z)); }
  __device__ __forceinline__ void emit8(int wid, int orow, int col, f32x4 a, f32x4 c) const {
    const int R = qrow(wid, orow); const u32x4 z = *(const u32x4*)(P + (size_t)R * 8192 + 6144 + h * 128 + col); u32x4 w;
    w.x = pk2(a[0] * silu(__uint_as_float(z.x << 16)), a[1] * silu(__uint_as_float(z.x & 0xffff0000u))); w.y = pk2(a[2] * silu(__uint_as_float(z.y << 16)), a[3] * silu(__uint_as_float(z.y & 0xffff0000u)));
    w.z = pk2(c[0] * silu(__uint_as_float(z.z << 16)), c[1] * silu(__uint_as_float(z.z & 0xffff0000u))); w.w = pk2(c[2] * silu(__uint_as_float(z.w << 16)), c[3] * silu(__uint_as_float(z.w & 0xffff0000u)));
    *(u32x4*)(Y + (size_t)R * DM + h * 128 + col) = w; }
};
}

__device__ __forceinline__ void phase_attn_swa_mfma(const Params& p, char* lds) {
    int tid = threadIdx.x; asm volatile("" : "+v"(tid));
    const int G = gridDim.x, bx = blockIdx.x, vcu = (G % 8 == 0) ? (bx % 8) * (G / 8) + bx / 8 : bx;
    for (int i = vcu; i < 512; i += G) { att::SwaUnitT<false> U; U.init(p, i); att::attn_unit<att::SwaUnitT<false>, 1, false>(U, lds, tid); }
    for (int i = vcu; i < 16; i += G) { att::SwaUnitT<true> U; U.init(p, i); att::attn_unit_skip(U, lds, tid); }
}
__device__ __forceinline__ void phase_attn_na_mfma(const Params& p, const float* rpb_layer, char* lds, bool with_meta) {
    int tid = threadIdx.x; asm volatile("" : "+v"(tid));
    const int G = gridDim.x, bx = blockIdx.x, vcu = (G % 8 == 0) ? (bx % 8) * (G / 8) + bx / 8 : bx;
    for (int i = vcu; i < 512; i += G) { att::NaUnitT<false> U; U.init(p, rpb_layer, lds, i); att::attn_unit_skip(U, lds, tid); }
    if (with_meta) for (int i = vcu; i < 64; i += G) { att::NaUnitT<true> U; U.init(p, rpb_layer, lds, i); att::attn_unit_skip(U, lds, tid); }
}


__device__ __forceinline__ void phase_attn_diff_mfma(const Params& p, char* lds) {
    int tid = threadIdx.x; asm volatile("" : "+v"(tid));
    const int G = gridDim.x, bx = blockIdx.x, vcu = (G % 8 == 0) ? (bx % 8) * (G / 8) + bx / 8 : bx;
    for (int i = vcu; i < 1024; i += G) { att::DiffUnitT<false> U; U.init(p.ws, i); att::attn_unit<att::DiffUnitT<false>, 1, false>(U, lds, tid); }
    if (vcu & 1) { att::DiffUnitT<true> U; U.init(p.ws, 1024 + (vcu >> 1)); att::attn_unit_splitk(U, lds, tid); }
}
__device__ __forceinline__ void phase_diff_combine(const Params& p) {
    int tid = threadIdx.x; asm volatile("" : "+v"(tid)); const int lane = tid & 63, wave = tid >> 6;
    const bf16_t* P = (const bf16_t*)(p.ws + WS_P); const bf16_t* OD = (const bf16_t*)(p.ws + WS_OD); bf16_t* Y = (bf16_t*)(p.ws + WS_Y);
    const int gw = blockIdx.x * NWAVES + wave, NGW = gridDim.x * NWAVES;
    const float l1 = p.lq1[lane] * p.lk1[lane] + p.lq1[lane + 64] * p.lk1[lane + 64], l2 = p.lq2[lane] * p.lk2[lane] + p.lq2[lane + 64] * p.lk2[lane + 64];
    const float lam = __expf(wave_sum(l1)) - __expf(wave_sum(l2)) + LAMBDA_INIT_L1;
    const f32x4 g = *(const f32x4*)(p.subg + 4 * lane);
    constexpr int NT4 = 4;
    for (int task0 = gw; task0 < MTOT * 8; task0 += NT4 * NGW) {
        uint2 a[NT4], c[NT4], zz[NT4]; int Rr[NT4], hh[NT4]; bool ok[NT4];
#pragma unroll
        for (int i = 0; i < NT4; ++i) { int task = task0 + i * NGW; ok[i] = task < MTOT * 8; if (!ok[i]) task = task0; Rr[i] = task >> 3; hh[i] = task & 7;
            a[i] = *(const uint2*)(OD + (size_t)Rr[i] * 4096 + hh[i] * 512 + 4 * lane); c[i] = *(const uint2*)(OD + (size_t)Rr[i] * 4096 + hh[i] * 512 + 256 + 4 * lane);
            zz[i] = *(const uint2*)(P + (size_t)Rr[i] * 8192 + 6144 + hh[i] * 256 + 4 * lane); }
#pragma unroll
        for (int i = 0; i < NT4; ++i) {
            float o[4];
            o[0] = __uint_as_float(a[i].x << 16) - lam * __uint_as_float(c[i].x << 16); o[1] = __uint_as_float(a[i].x & 0xffff0000u) - lam * __uint_as_float(c[i].x & 0xffff0000u);
            o[2] = __uint_as_float(a[i].y << 16) - lam * __uint_as_float(c[i].y << 16); o[3] = __uint_as_float(a[i].y & 0xffff0000u) - lam * __uint_as_float(c[i].y & 0xffff0000u);
            const float ss = wave_sum(o[0] * o[0] + o[1] * o[1] + o[2] * o[2] + o[3] * o[3]);
            const float rinv = 1.f / sqrtf(ss * (1.f / 256.f) + RMS_EPS) * (1.f - LAMBDA_INIT_L1);
            const float y0 = o[0] * rinv * g[0] * silu(__uint_as_float(zz[i].x << 16)), y1 = o[1] * rinv * g[1] * silu(__uint_as_float(zz[i].x & 0xffff0000u));
            const float y2 = o[2] * rinv * g[2] * silu(__uint_as_float(zz[i].y << 16)), y3 = o[3] * rinv * g[3] * silu(__uint_as_float(zz[i].y & 0xffff0000u));
            uint2 ov; ov.x = pk2(y0, y1); ov.y = pk2(y2, y3);
            if (ok[i]) *(uint2*)(Y + (size_t)Rr[i] * DM + hh[i] * 256 + 4 * lane) = ov; }
    }
}

#define RLX_AGENT __ATOMIC_RELAXED, __HIP_MEMORY_SCOPE_AGENT
#define XB_TMO      128
#define XB_XCNT(j)  (256  + 64 * (j))
#define XB_XSUB(j)  (1280 + 64 * (j))
#define XB_XGEN(j)  (2304 + 64 * (j))
#define XB_TOP      3328
#define XB_TOPGEN   3392
#define XCD_BAR_WORDS 3456
#define XB_SPIN_CAP (1u << 18)

__device__ __forceinline__ unsigned xb_ld(unsigned* p)              { return __hip_atomic_load(p, __ATOMIC_RELAXED, __HIP_MEMORY_SCOPE_AGENT); }
__device__ __forceinline__ unsigned xb_add(unsigned* p, unsigned v) { return __hip_atomic_fetch_add(p, v, __ATOMIC_RELAXED, __HIP_MEMORY_SCOPE_AGENT); }
__device__ __forceinline__ unsigned xb_xcc_id() { return (unsigned)__builtin_amdgcn_s_getreg((3 << 11) | 20) & 0xFu; }
#define XB_SPIN(cond, bar) do { unsigned _sp = 0; while (cond) { __builtin_amdgcn_s_sleep(1); \
    if ((++_sp & 255u) == 0u) { if (xb_ld(&(bar)[XB_TMO])) break; if (_sp > XB_SPIN_CAP) { atomicAdd(&(bar)[XB_TMO], 1u); break; } } } } while (0)

struct XcdBarrier {
    unsigned* bar; unsigned x;
    volatile LAS unsigned* st;
};

__device__ __forceinline__ XcdBarrier xcd_barrier_post(unsigned* bar, volatile LAS unsigned* st) {
    XcdBarrier b; b.bar = bar; b.x = xb_xcc_id(); b.st = st;
    if (threadIdx.x == 0) (void)xb_add(&bar[XB_XCNT(b.x)], 1u);
    return b;
}
__device__ __forceinline__ void xcd_barrier_complete(unsigned* bar, unsigned x, unsigned& nloc, unsigned& nx) {
    const unsigned G = gridDim.x * gridDim.y * gridDim.z;
    unsigned sum, cnt, mine, sp = 0u;
    for (;;) {
        sum = 0u; cnt = 0u; mine = 0u;
#pragma unroll
        for (unsigned j = 0; j < 16; ++j) { const unsigned c = xb_ld(&bar[XB_XCNT(j)]); sum += c; cnt += (c > 0u) ? 1u : 0u; mine = (j == x) ? c : mine; }
        if (sum == G) break;
        __builtin_amdgcn_s_sleep(1);
        if ((++sp & 255u) == 0u) { if (xb_ld(&bar[XB_TMO])) break; if (sp > XB_SPIN_CAP) { atomicAdd(&bar[XB_TMO], 1u); break; } }
    }
    nloc = mine > 0u ? mine : 1u; nx = cnt > 0u ? cnt : 1u;
}

__device__ __forceinline__ void xcd_barrier(const XcdBarrier& b) {
    asm volatile("s_waitcnt vmcnt(0)" ::: "memory");
    __syncthreads();
    if (threadIdx.x == 0) {
        unsigned* bar = b.bar;
        __builtin_amdgcn_s_waitcnt(0);
        unsigned nloc = b.st[0], nx = b.st[1];
        if (nloc == 0u) { xcd_barrier_complete(bar, b.x, nloc, nx); b.st[0] = nloc; b.st[1] = nx; }
        const unsigned old = xb_add(&bar[XB_XSUB(b.x)], 1u);
        const unsigned gen = old / nloc;
        if (old + 1u == (gen + 1u) * nloc) {
            __builtin_amdgcn_fence(__ATOMIC_RELEASE, "agent");
            asm volatile("s_waitcnt vmcnt(0)" ::: "memory");
            const unsigned og = xb_add(&bar[XB_TOP], 1u);
            const unsigned tg = og / nx;
            if (og + 1u == (tg + 1u) * nx) xb_add(&bar[XB_TOPGEN], 1u);
            else XB_SPIN(xb_ld(&bar[XB_TOPGEN]) == tg, bar);
            __builtin_amdgcn_fence(__ATOMIC_ACQUIRE, "agent");
            xb_add(&bar[XB_XGEN(b.x)], 1u);
            asm volatile("s_waitcnt vmcnt(0)" ::: "memory");
        } else {
            XB_SPIN(xb_ld(&bar[XB_XGEN(b.x)]) == gen, bar);
            __builtin_amdgcn_fence(__ATOMIC_ACQUIRE, "agent");
            asm volatile("s_waitcnt vmcnt(0)" ::: "memory");
        }
    }
    __syncthreads();
}


#define GRID_SYNC() do { XcdBarrier b_; b_.bar = (unsigned*)(p.ws + WS_CTL); b_.x = xb_xcc_id(); b_.st = (volatile LAS unsigned*)((LAS unsigned char*)lds_raw + LDS_MISC); xcd_barrier(b_); } while (0)
__global__ void __launch_bounds__(NTHREADS, 2) mega(Params p) {
    extern __shared__ __attribute__((aligned(16))) unsigned char lds_raw[];
    float* lds = (float*)lds_raw; PG8_LAS unsigned char* lds3 = (PG8_LAS unsigned char*)lds_raw;
    volatile LAS unsigned* misc = (volatile LAS unsigned*)((LAS unsigned char*)lds_raw + LDS_MISC);
    if (threadIdx.x < 16) misc[threadIdx.x] = 0u;
    __syncthreads();
    (void)xcd_barrier_post((unsigned*)(p.ws + WS_CTL), misc);
    const bf16_t* HB = (const bf16_t*)(p.ws + WS_HB);
    phase_prep(p, lds);
    GRID_SYNC();
    for (int layer = 0; layer < 4; ++layer) {
        const int kind = layer % 3;
        const bf16_t* Wt = (const bf16_t*)(p.ws + (layer == 0 ? WS_WA0 : layer == 1 ? WS_WB : layer == 2 ? WS_WC : WS_WA1));
        { const int N = kind == 2 ? 5120 : 8192; pg8::Gemm g{HB, Wt, MREAL, N, DM}; pg8::StaticOrder S; S.init(MREAL, N, (int)gridDim.x, (int)blockIdx.x);
          pg8::EpiBf16s E{(bf16_t*)(p.ws + WS_P), N, 2048, QPRE};
          pg8::gemm_phase<pg8::EpiBf16s, pg8::StaticOrder, true, true>(lds3, g, S, E);
          phase_gemm_meta<0, 2>(HB, Wt, N, p.ws + WS_P, nullptr, lds, kind == 2 ? 128 : 0); }
        GRID_SYNC();
        if (kind == 0) phase_attn_na_mfma(p, p.rpb_a + (size_t)(layer / 3) * 16 * 15 * 31, (char*)lds_raw, layer < 3);
        else if (kind == 1) { phase_attn_diff_mfma(p, (char*)lds_raw); GRID_SYNC(); phase_diff_combine(p); }
        else phase_attn_swa_mfma(p, (char*)lds_raw);
        GRID_SYNC();
        { pg8::Gemm g{(const bf16_t*)(p.ws + WS_Y), (const bf16_t*)(p.ws + WS_WO) + (size_t)layer * DM * DM, MREAL, DM, DM}; pg8::StaticOrder S; S.init(MREAL, DM, (int)gridDim.x, (int)blockIdx.x);
          const float* lg = layer ? p.ln_g + (layer - 1) * DM : nullptr; const float* lb = layer ? p.ln_b + (layer - 1) * DM : nullptr;
          pg8::EpiResF32 E{(float*)(p.ws + WS_H32), layer == 0 ? p.x : nullptr, (const float*)(p.ws + WS_ST), lg, lb, DM, ALPHA};
          pg8::gemm_phase<pg8::EpiResF32, pg8::StaticOrder, true, true>(lds3, g, S, E);
          if (layer < 3) phase_gemm_meta<1, 1>((const bf16_t*)(p.ws + WS_Y), (const bf16_t*)(p.ws + WS_WO) + (size_t)layer * DM * DM, DM, p.ws + WS_H32, layer ? (const float*)(p.ws + WS_ST) : nullptr, lds, 0, lg, lb); }
        GRID_SYNC();
        phase_ln(p, layer, layer == 3, layer == 3 ? MREAL : MTOT);
        if (layer < 3) GRID_SYNC();
    }
}

extern "C" void kernel_launch(void* const* d_in, const int* in_sizes, int n_in, void* d_out, int out_size, void* d_ws, size_t ws_size, hipStream_t stream) {
    if (n_in != 15 || ws_size < WS_END) { fprintf(stderr, "kernel_launch: unexpected n_in %d or ws_size %zu (< %zu)\n", n_in, ws_size, (size_t)WS_END); return; }
    Params p{};
    p.x = (const float*)d_in[0]; p.meta = (const float*)d_in[1]; p.w_in_a = (const float*)d_in[2]; p.rpb_a = (const float*)d_in[3]; p.w_in_b = (const float*)d_in[4];
    p.lq1 = (const float*)d_in[5]; p.lk1 = (const float*)d_in[6]; p.lq2 = (const float*)d_in[7]; p.lk2 = (const float*)d_in[8]; p.subg = (const float*)d_in[9];
    p.w_in_c = (const float*)d_in[10]; p.sink = (const float*)d_in[11]; p.w_out = (const float*)d_in[12]; p.ln_g = (const float*)d_in[13]; p.ln_b = (const float*)d_in[14];
    p.out = (float*)d_out; p.ws = (unsigned char*)d_ws;
    constexpr int LDSB = LDS_TOTAL;
    static int grid = 0;
    if (grid == 0) {
        int dev = 0, cus = 0, per_cu = 0;
        (void)hipGetDevice(&dev);
        (void)hipDeviceGetAttribute(&cus, hipDeviceAttributeMultiprocessorCount, dev);
        (void)hipFuncSetAttribute((const void*)mega, hipFuncAttributeMaxDynamicSharedMemorySize, LDSB);
        (void)hipOccupancyMaxActiveBlocksPerMultiprocessor(&per_cu, (const void*)mega, NTHREADS, LDSB);
        if (per_cu < 1) fprintf(stderr, "kernel_launch: occupancy query says %d blocks/CU\n", per_cu);
        (void)hipGetLastError();
        grid = cus;
    }
    (void)hipMemsetAsync((char*)d_ws + WS_CTL, 0, CTL_BYTES, stream);
    hipLaunchKernelGGL(mega, dim3(grid), dim3(NTHREADS), LDSB, stream, p);
    const hipError_t le = hipPeekAtLastError();
    if (le != hipSuccess) fprintf(stderr, "kernel_launch: launch failed: %s (grid %d)\n", hipGetErrorName(le), grid);
}
```
